# Optimizing an MI355X kernel written in HIP

```python
import math
import jax, jax.numpy as jnp
from jax import lax
import numpy as np

D_MODEL = 1024
BATCH = 8
SEQ = 2048
DEPTH = 4
DEC_BATCH = 128
DEC_SEQ = 1
PAST_LEN = 16384
PAGE_SIZE = 128

MIX_WIDTH = D_MODEL
GROUP_WIDTH = MIX_WIDTH // 2
LRU_HEADS = 8
LRU_HEAD_DIM = GROUP_WIDTH // LRU_HEADS
LRU_C = 8.0
CONV_W = 4
POOL_WINDOWS = (2, 4, 8, 16)
POOL_GROUPS = len(POOL_WINDOWS)
POOL_GROUP = GROUP_WIDTH // POOL_GROUPS
POOL_MAX_WIN = max(POOL_WINDOWS)
D_FF = 2816
LN_EPS = 1e-5
DEEPNORM_ALPHA = (2.0 * DEPTH) ** 0.25
DEEPNORM_BETA = (8.0 * DEPTH) ** -0.25

kernel_name = "hybrid_rglru_pool_macaron_deepnorm_step"


def _layernorm(x, g, b):
    xf = x.astype(jnp.float32)
    mu = jnp.mean(xf, axis=-1, keepdims=True)
    var = jnp.mean(jnp.square(xf - mu), axis=-1, keepdims=True)
    y = (xf - mu) * lax.rsqrt(var + LN_EPS) * g.astype(jnp.float32) + b.astype(jnp.float32)
    return y.astype(x.dtype)


def _swiglu(x, w_gate, w_up, w_down):
    hid = jax.nn.silu(jnp.einsum("btd,df->btf", x, w_gate)) * jnp.einsum("btd,df->btf", x, w_up)
    return jnp.einsum("btf,fd->btd", hid, w_down)


def _causal_conv(u, prefix, w, b):
    T = u.shape[1]
    up = jnp.concatenate([prefix.astype(u.dtype), u], axis=1)
    out = b + up[:, 0:T] * w[0]
    for k in range(1, CONV_W):
        out = out + up[:, k:k + T] * w[k]
    return out, up[:, up.shape[1] - (CONV_W - 1):]


def _rglru(xc, h0, gate_a_w, gate_a_b, gate_x_w, gate_x_b, lam):
    B, T, C = xc.shape
    xh = xc.reshape(B, T, LRU_HEADS, LRU_HEAD_DIM)
    r = jax.nn.sigmoid(jnp.einsum("bthi,hij->bthj", xh, gate_a_w).reshape(B, T, C) + gate_a_b)
    i = jax.nn.sigmoid(jnp.einsum("bthi,hij->bthj", xh, gate_x_w).reshape(B, T, C) + gate_x_b)
    log_a = -LRU_C * r.astype(jnp.float32) * jax.nn.softplus(-lam.astype(jnp.float32))
    a = jnp.exp(log_a)
    mult = jnp.sqrt(-jnp.expm1(2.0 * log_a))
    u = mult * (i * xc).astype(jnp.float32)

    def step(h, au):
        a_t, u_t = au
        h = a_t * h + u_t
        return h, h

    h_T, hs = lax.scan(step, h0.astype(jnp.float32),
                       (jnp.swapaxes(a, 0, 1), jnp.swapaxes(u, 0, 1)))
    return jnp.swapaxes(hs, 0, 1).astype(xc.dtype), h_T.astype(xc.dtype)


def _pool_mix(u, prefix, start_pos, pool_w, pool_scale):
    B, T, C = u.shape
    P = POOL_MAX_WIN - 1
    up = jnp.concatenate([prefix.astype(u.dtype), u], axis=1)
    cs = jnp.cumsum(up.astype(jnp.float32), axis=1)
    cs = jnp.concatenate([jnp.zeros((B, 1, C), jnp.float32), cs], axis=1)
    end = cs[:, P + 1:]
    pos = start_pos + jnp.arange(T, dtype=jnp.int32)
    means = []
    for g, w in enumerate(POOL_WINDOWS):
        lo, hi = g * POOL_GROUP, (g + 1) * POOL_GROUP
        begin = cs[:, P + 1 - w:P + 1 - w + T, lo:hi]
        cnt = jnp.minimum(w, pos + 1).astype(jnp.float32)[None, :, None]
        means.append((end[:, :, lo:hi] - begin) / cnt)
    pooled = (jnp.concatenate(means, axis=-1) - u.astype(jnp.float32)).astype(u.dtype)
    mixed = jnp.einsum("btgi,gij->btgj", pooled.reshape(B, T, POOL_GROUPS, POOL_GROUP), pool_w)
    return mixed.reshape(B, T, C) * pool_scale, up[:, up.shape[1] - P:]


def _layer(x, h0, conv_buf, pool_buf, start_pos,
           ln_g, ln_b, w1_gate, w1_up, w1_down, w_in, conv_w, conv_b,
           gate_a_w, gate_a_b, gate_x_w, gate_x_b, lru_lambda, pool_w, pool_scale,
           w_out, w2_gate, w2_up, w2_down):
    x = _layernorm(DEEPNORM_ALPHA * x + 0.5 * _swiglu(x, w1_gate, w1_up, w1_down), ln_g[0], ln_b[0])
    proj = jnp.einsum("btd,de->bte", x, w_in)
    u_lru = proj[..., :GROUP_WIDTH]
    u_gate = proj[..., GROUP_WIDTH:2 * GROUP_WIDTH]
    u_pool = proj[..., 2 * GROUP_WIDTH:]
    xc, conv_new = _causal_conv(u_lru, conv_buf, conv_w, conv_b)
    h, h_T = _rglru(xc, h0, gate_a_w, gate_a_b, gate_x_w, gate_x_b, lru_lambda)
    y_lru = h * jax.nn.gelu(u_gate)
    y_pool, pool_new = _pool_mix(u_pool, pool_buf, start_pos, pool_w, pool_scale)
    mix = jnp.einsum("bte,ed->btd", jnp.concatenate([y_lru, y_pool], axis=-1), w_out)
    x = _layernorm(DEEPNORM_ALPHA * x + mix, ln_g[1], ln_b[1])
    x = _layernorm(DEEPNORM_ALPHA * x + 0.5 * _swiglu(x, w2_gate, w2_up, w2_down), ln_g[2], ln_b[2])
    return x, h_T, conv_new, pool_new


def setup_inputs(seed: int = 0) -> dict:
    key = jax.random.key(seed)
    ks = jax.random.split(key, 32)
    f32 = jnp.float32
    nrm = lambda k, shape, s: jax.random.normal(k, shape, f32) * s
    x_prompt = nrm(ks[0], (BATCH, SEQ, D_MODEL), 1.0)
    x_sample = nrm(ks[1], (DEC_BATCH, DEC_SEQ, D_MODEL), 1.0)
    state_lru_h = nrm(ks[2], (DEPTH, DEC_BATCH, GROUP_WIDTH), 0.5)
    state_conv = nrm(ks[3], (DEPTH, DEC_BATCH, CONV_W - 1, GROUP_WIDTH), 1.0)
    state_pool = nrm(ks[4], (DEPTH, DEC_BATCH, POOL_MAX_WIN - 1, GROUP_WIDTH), 1.0)
    ln_g = 1.0 + nrm(ks[5], (DEPTH, 3, D_MODEL), 0.05)
    ln_b = nrm(ks[6], (DEPTH, 3, D_MODEL), 0.02)
    w1_gate = nrm(ks[7], (DEPTH, D_MODEL, D_FF), D_MODEL ** -0.5)
    w1_up = nrm(ks[8], (DEPTH, D_MODEL, D_FF), D_MODEL ** -0.5)
    w1_down = nrm(ks[9], (DEPTH, D_FF, D_MODEL), DEEPNORM_BETA * D_FF ** -0.5)
    w_in = nrm(ks[10], (DEPTH, D_MODEL, 3 * GROUP_WIDTH), D_MODEL ** -0.5)
    conv_w = nrm(ks[11], (DEPTH, CONV_W, GROUP_WIDTH), CONV_W ** -0.5)
    conv_b = nrm(ks[12], (DEPTH, GROUP_WIDTH), 0.02)
    gate_a_w = nrm(ks[13], (DEPTH, LRU_HEADS, LRU_HEAD_DIM, LRU_HEAD_DIM), LRU_HEAD_DIM ** -0.5)
    gate_a_b = nrm(ks[14], (DEPTH, GROUP_WIDTH), 0.02)
    gate_x_w = nrm(ks[15], (DEPTH, LRU_HEADS, LRU_HEAD_DIM, LRU_HEAD_DIM), LRU_HEAD_DIM ** -0.5)
    gate_x_b = nrm(ks[16], (DEPTH, GROUP_WIDTH), 0.02)
    a0 = jax.random.uniform(ks[17], (DEPTH, GROUP_WIDTH), f32, 0.9, 0.999)
    s = a0 ** (1.0 / LRU_C)
    lru_lambda = jnp.log(s) - jnp.log1p(-s)
    pool_w = nrm(ks[18], (DEPTH, POOL_GROUPS, POOL_GROUP, POOL_GROUP), POOL_GROUP ** -0.5)
    pool_scale = 1.0 + nrm(ks[19], (DEPTH, GROUP_WIDTH), 0.1)
    w_out = nrm(ks[20], (DEPTH, MIX_WIDTH, D_MODEL), DEEPNORM_BETA * MIX_WIDTH ** -0.5)
    w2_gate = nrm(ks[21], (DEPTH, D_MODEL, D_FF), D_MODEL ** -0.5)
    w2_up = nrm(ks[22], (DEPTH, D_MODEL, D_FF), D_MODEL ** -0.5)
    w2_down = nrm(ks[23], (DEPTH, D_FF, D_MODEL), DEEPNORM_BETA * D_FF ** -0.5)
    return {"x_prompt": x_prompt, "x_sample": x_sample,
            "state_lru_h": state_lru_h, "state_conv": state_conv, "state_pool": state_pool,
            "ln_g": ln_g, "ln_b": ln_b,
            "w1_gate": w1_gate, "w1_up": w1_up, "w1_down": w1_down,
            "w_in": w_in, "conv_w": conv_w, "conv_b": conv_b,
            "gate_a_w": gate_a_w, "gate_a_b": gate_a_b,
            "gate_x_w": gate_x_w, "gate_x_b": gate_x_b, "lru_lambda": lru_lambda,
            "pool_w": pool_w, "pool_scale": pool_scale, "w_out": w_out,
            "w2_gate": w2_gate, "w2_up": w2_up, "w2_down": w2_down}


def reference(x_prompt, x_sample, state_lru_h, state_conv, state_pool,
              ln_g, ln_b, w1_gate, w1_up, w1_down, w_in, conv_w, conv_b,
              gate_a_w, gate_a_b, gate_x_w, gate_x_b, lru_lambda, pool_w, pool_scale,
              w_out, w2_gate, w2_up, w2_down):
    dt = x_prompt.dtype
    xp, xs = x_prompt, x_sample
    p_h, p_conv, p_pool, s_h, s_conv, s_pool = [], [], [], [], [], []
    for l in range(DEPTH):
        params = (ln_g[l], ln_b[l], w1_gate[l], w1_up[l], w1_down[l], w_in[l], conv_w[l], conv_b[l],
                  gate_a_w[l], gate_a_b[l], gate_x_w[l], gate_x_b[l], lru_lambda[l],
                  pool_w[l], pool_scale[l], w_out[l], w2_gate[l], w2_up[l], w2_down[l])
        xp, h_T, cbuf, pbuf = _layer(
            xp, jnp.zeros((BATCH, GROUP_WIDTH), dt),
            jnp.zeros((BATCH, CONV_W - 1, GROUP_WIDTH), dt),
            jnp.zeros((BATCH, POOL_MAX_WIN - 1, GROUP_WIDTH), dt),
            0, *params)
        p_h.append(h_T); p_conv.append(cbuf); p_pool.append(pbuf)
        xs, h_T, cbuf, pbuf = _layer(
            xs, state_lru_h[l], state_conv[l], state_pool[l], PAST_LEN, *params)
        s_h.append(h_T); s_conv.append(cbuf); s_pool.append(pbuf)
    return (xp, xs,
            jnp.stack(p_h), jnp.stack(p_conv), jnp.stack(p_pool),
            jnp.stack(s_h), jnp.stack(s_conv), jnp.stack(s_pool))
```

```cpp
#include <hip/hip_runtime.h>
#include <hip/hip_cooperative_groups.h>
#include <cstdio>
namespace cg = cooperative_groups;
namespace pg8 {
#define PG8_LAS __attribute__((address_space(3)))
typedef unsigned short bf16_t;
typedef short bf16x8 __attribute__((ext_vector_type(8)));
typedef float f32x4 __attribute__((ext_vector_type(4)));
typedef unsigned u32x4 __attribute__((ext_vector_type(4)));
constexpr int BM = 256, BK = 64, HALF = 128, HTB = HALF * BK * 2  , STAGE_BYTES = 8 * HTB, NXCD = 8, WGM = 8;

__host__ __device__ __forceinline__ int lds_byte(int r, int c) { const int st = (r >> 4) * 2 + (c >> 5), rr = r & 15, cc = c & 31, ob = rr * 64 + cc * 2; return st * 1024 + (ob ^ (((ob >> 9) & 1) << 5)); }
__host__ __device__ __forceinline__ void stage_rc(int b, int& R, int& C) { const int st = b / 1024, sb = b % 1024, swz = sb ^ (((sb >> 9) & 1) << 5); R = (st >> 1) * 16 + swz / 64; C = (st & 1) * 32 + (swz % 64) / 2; }
__host__ __device__ __forceinline__ int perm32(int rho) { const int n = rho >> 4, i = rho & 15; return 8 * (i >> 2) + 4 * n + (i & 3); }

struct Unit { int pm, pn; };
struct Gemm { const bf16_t* A; const bf16_t* Bt; int M, N, K; };

struct StaticOrder {
    int nM, nN, nwg, G, c;
    __host__ __device__ void init(int M, int N, int G_, int c_) { nM = M / BM; nN = N / BM; nwg = nM * nN; G = G_; c = c_; }
    __host__ __device__ bool next(int i, Unit& u) const {
        const long L = (long)i * G + c; if (L >= nwg) return false;
        int wgid = (int)L; { const int q = nwg / NXCD, r = nwg % NXCD, xcd = wgid % NXCD, off = wgid / NXCD; wgid = (xcd < r ? xcd * (q + 1) : r * (q + 1) + (xcd - r) * q) + off; }
        const int nig = WGM * nN, gid = wgid / nig, fm = gid * WGM, gsz = (nM - fm) < WGM ? (nM - fm) : WGM;
        u.pm = fm + ((wgid % nig) % gsz); u.pn = (wgid % nig) / gsz; return true;
    }
    __device__ __forceinline__ void a_ready(const Unit&) const {}
    __device__ __forceinline__ void done(const Unit&) const {}
};
__device__ __forceinline__ unsigned cvt_pk_bf16(float lo, float hi) { unsigned r; asm volatile("v_cvt_pk_bf16_f32 %0, %1, %2" : "=v"(r) : "v"(lo), "v"(hi)); return r; }
typedef float f32x2 __attribute__((ext_vector_type(2)));
struct EpiF32 {
    static constexpr bool PERM = false, AFTER_DRAIN = false;
    float* C; int ldc; const float* bias;
    __device__ __forceinline__ void operator()(const f32x4 (&acc)[2][2][4][2], const Unit& u, int wr, int wc, int fr, int fq) const {
        const int row0 = u.pm * BM + wr * 64 + fr, col0 = u.pn * BM + wc * 32 + 4 * fq;
        f32x4 bv[2][2];
#pragma unroll
        for (int bj = 0; bj < 2; ++bj)
#pragma unroll
            for (int n = 0; n < 2; ++n) bv[bj][n] = bias ? *(const f32x4*)(bias + col0 + bj * HALF + n * 16) : (f32x4){0.f, 0.f, 0.f, 0.f};
#pragma unroll
        for (int ai = 0; ai < 2; ++ai)
#pragma unroll
            for (int m = 0; m < 4; ++m) { float* rowp = C + (size_t)(row0 + ai * HALF + m * 16) * ldc + col0;
#pragma unroll
                for (int bj = 0; bj < 2; ++bj)
#pragma unroll
                    for (int n = 0; n < 2; ++n) *(f32x4*)(rowp + bj * HALF + n * 16) = acc[ai][bj][m][n] + bv[bj][n]; }
    }
};
template <class Epi, class Sched, bool STAMP = false>
__device__ __forceinline__ void gemm_phase(PG8_LAS unsigned char* lds, const Gemm g, const Sched& S, const Epi& E, unsigned long long* stamps) {
    int tid_l = threadIdx.x; asm volatile("" : "+v"(tid_l));
    const int tid = tid_l, wid = __builtin_amdgcn_readfirstlane(tid >> 6), lane = tid & 63, wr = wid >> 2, wc = wid & 3, fr = lane & 15, fq = lane >> 4;
    const int K = g.K, nt = K / BK;
    int ts_lo = 0, ts_hi = 0, nts = 0; const unsigned long long rt_entry = STAMP ? (unsigned long long)wall_clock64() : 0ull;
#define PG8_STAMP() do { if (STAMP && wid == 0 && nts < 64) { const unsigned long long _c = (unsigned long long)clock64(); \
        ts_lo = (lane == nts) ? (int)(unsigned)_c : ts_lo; ts_hi = (lane == nts) ? (int)(unsigned)(_c >> 32) : ts_hi; ++nts; } } while (0)
    PG8_STAMP();
    unsigned voffA[2], voffB[2];
#pragma unroll
    for (int i = 0; i < 2; ++i) { int R, C; stage_rc(tid * 16 + i * 8192, R, C); const int Rb = Epi::PERM ? ((R & ~31) + perm32(R & 31)) : R;
        voffA[i] = (unsigned)(R * K + C) * 2u; voffB[i] = (unsigned)(Rb * K + C) * 2u; }
    const size_t kstep = (size_t)(BK * 2);
    const size_t hstep = (size_t)HALF * K * 2;
    const size_t tstep = 2 * hstep;
    const unsigned ldsw = (unsigned)wid * 1024u;
    const int aoff = lds_byte(wr * 64 + fr, fq * 8), boff = lds_byte(wc * 32 + fr, fq * 8);
#define PG8_SA(b, h) (((b) * 2 + (h)) * HTB)
#define PG8_SB(b, h) ((4 + (b) * 2 + (h)) * HTB)
#define PG8_STAGE(bufoff, gbase, voff) do { _Pragma("unroll") for (int _i = 0; _i < 2; ++_i) \
        __builtin_amdgcn_global_load_lds((const unsigned*)((const char*)(gbase) + (voff)[_i]), (PG8_LAS unsigned*)(lds + (bufoff) + ldsw + _i * 8192), 16, 0, 0); } while (0)
#define PG8_LDA(dst, b, h) do { _Pragma("unroll") for (int m = 0; m < 4; ++m) _Pragma("unroll") for (int k = 0; k < 2; ++k) dst[m][k] = *(const PG8_LAS bf16x8*)(lds + PG8_SA(b, h) + aoff + m * 2048 + k * 1024); } while (0)
#define PG8_LDB(dst, b, h) do { _Pragma("unroll") for (int n = 0; n < 2; ++n) _Pragma("unroll") for (int k = 0; k < 2; ++k) dst[n][k] = *(const PG8_LAS bf16x8*)(lds + PG8_SB(b, h) + boff + n * 2048 + k * 1024); } while (0)
#define PG8_MMA(ai, bj, At, Bt) do { __builtin_amdgcn_s_setprio(1); _Pragma("unroll") for (int m = 0; m < 4; ++m) _Pragma("unroll") for (int n = 0; n < 2; ++n) _Pragma("unroll") for (int k = 0; k < 2; ++k) \
        acc[ai][bj][m][n] = __builtin_amdgcn_mfma_f32_16x16x32_bf16(Bt[n][k], At[m][k], acc[ai][bj][m][n], 0, 0, 0); __builtin_amdgcn_s_setprio(0); } while (0)
#define PG8_WAIT_V(n) asm volatile("s_waitcnt vmcnt(" #n ")" ::: "memory")
#define PG8_WAIT_L(n) asm volatile("s_waitcnt lgkmcnt(" #n ")" ::: "memory")
#define PG8_BAR __builtin_amdgcn_s_barrier()
#define PG8_SCHED __builtin_amdgcn_sched_barrier(0)
    Unit cur, nxt; int ui = 0;
    if (!S.next(0, cur)) return;
    f32x4 acc[2][2][4][2];
#pragma unroll
    for (int a = 0; a < 2; ++a)
#pragma unroll
        for (int b = 0; b < 2; ++b)
#pragma unroll
            for (int m = 0; m < 4; ++m)
#pragma unroll
                for (int n = 0; n < 2; ++n) acc[a][b][m][n] = (f32x4){0.f, 0.f, 0.f, 0.f};
    bf16x8 At[4][2], B0[2][2], B1[2][2];
    const char* cA = (const char*)g.A + (size_t)cur.pm * tstep; const char* cB = (const char*)g.Bt + (size_t)cur.pn * tstep;
    S.a_ready(cur);
    PG8_STAGE(PG8_SB(0, 0), cB, voffB); PG8_STAGE(PG8_SA(0, 0), cA, voffA); PG8_STAGE(PG8_SB(0, 1), cB + hstep, voffB); PG8_STAGE(PG8_SA(0, 1), cA + hstep, voffA);
    if (wr == 1) PG8_BAR;
    PG8_WAIT_V(4); PG8_BAR;
    PG8_STAGE(PG8_SB(1, 0), cB + kstep, voffB); PG8_STAGE(PG8_SA(1, 0), cA + kstep, voffA); PG8_STAGE(PG8_SB(1, 1), cB + hstep + kstep, voffB);
    PG8_WAIT_V(6); PG8_BAR;
    PG8_STAMP();
    for (;;) {
        const bool has_next = S.next(ui + 1, nxt);
        const char* nA = has_next ? (const char*)g.A + (size_t)nxt.pm * tstep : cA; const char* nB = has_next ? (const char*)g.Bt + (size_t)nxt.pn * tstep : cB;
        for (int t = 0; t < nt; t += 2) {
            const bool last = (t == nt - 2);
            const char* a1 = cA + (size_t)(t + 1) * kstep;
            const char* a2 = last ? nA : cA + (size_t)(t + 2) * kstep; const char* b2 = last ? nB : cB + (size_t)(t + 2) * kstep;
            const char* a3 = a2 + kstep; const char* b3 = b2 + kstep;
            if (last && has_next) S.a_ready(nxt);
            PG8_LDB(B0, 0, 0); PG8_SCHED; PG8_LDA(At, 0, 0); PG8_STAGE(PG8_SA(1, 1), a1 + hstep, voffA);
            PG8_WAIT_L(8); PG8_BAR; PG8_WAIT_L(0); PG8_MMA(0, 0, At, B0); PG8_BAR; PG8_SCHED;
            PG8_LDB(B1, 0, 1); PG8_STAGE(PG8_SB(0, 0), b2, voffB);
            PG8_BAR; PG8_WAIT_L(0); PG8_MMA(0, 1, At, B1); PG8_BAR;
            PG8_LDA(At, 0, 1); PG8_STAGE(PG8_SA(0, 0), a2, voffA);
            PG8_BAR; PG8_WAIT_L(0); PG8_MMA(1, 0, At, B0); PG8_BAR; PG8_SCHED;
            PG8_STAGE(PG8_SB(0, 1), b2 + hstep, voffB);
            PG8_WAIT_V(6); PG8_BAR; PG8_MMA(1, 1, At, B1); PG8_BAR;
            PG8_LDB(B0, 1, 0); PG8_SCHED; PG8_LDA(At, 1, 0); PG8_STAGE(PG8_SA(0, 1), a2 + hstep, voffA);
            PG8_WAIT_L(8); PG8_BAR; PG8_WAIT_L(0); PG8_MMA(0, 0, At, B0); PG8_BAR; PG8_SCHED;
            PG8_LDB(B1, 1, 1); PG8_STAGE(PG8_SB(1, 0), b3, voffB);
            PG8_BAR; PG8_WAIT_L(0); PG8_MMA(0, 1, At, B1); PG8_BAR;
            PG8_LDA(At, 1, 1); PG8_STAGE(PG8_SA(1, 0), a3, voffA);
            PG8_BAR; PG8_WAIT_L(0); PG8_MMA(1, 0, At, B0); PG8_BAR; PG8_SCHED;
            PG8_STAGE(PG8_SB(1, 1), b3 + hstep, voffB);
            PG8_WAIT_V(6); PG8_BAR; PG8_MMA(1, 1, At, B1); PG8_BAR;
        }
        PG8_STAMP();
        if constexpr (!Epi::AFTER_DRAIN) { E(acc, cur, wr, wc, fr, fq); S.done(cur); }
        PG8_STAMP();
        if (!has_next) break;
#pragma unroll
        for (int a = 0; a < 2; ++a)
#pragma unroll
            for (int b = 0; b < 2; ++b)
#pragma unroll
                for (int m = 0; m < 4; ++m)
#pragma unroll
                    for (int n = 0; n < 2; ++n) acc[a][b][m][n] = (f32x4){0.f, 0.f, 0.f, 0.f};
        cur = nxt; cA = nA; cB = nB; ++ui;
    }
    PG8_WAIT_V(0);
    if (wr == 0) PG8_BAR;
    PG8_BAR;
    if constexpr (Epi::AFTER_DRAIN) { E.fused(acc, cur, wr, wc, fr, fq, lds, wid, lane); S.done(cur); }
    PG8_STAMP();
    if (STAMP && wid == 0) { stamps[lane] = lane < nts ? (((unsigned long long)(unsigned)ts_hi << 32) | (unsigned)ts_lo) : 0ull;
        if (lane == 62) stamps[62] = rt_entry; if (lane == 63) stamps[63] = (unsigned long long)wall_clock64(); }
#undef PG8_STAMP
#undef PG8_SA
#undef PG8_SB
#undef PG8_STAGE
#undef PG8_LDA
#undef PG8_LDB
#undef PG8_MMA
#undef PG8_WAIT_V
#undef PG8_WAIT_L
#undef PG8_BAR
#undef PG8_SCHED
}
}

#define LAS __attribute__((address_space(3)))
using pg8::bf16_t; using pg8::bf16x8; using pg8::f32x4; using pg8::u32x4; using pg8::Unit; using pg8::BM; using pg8::HALF;
typedef float f32x2 __attribute__((ext_vector_type(2)));
typedef unsigned u32x2 __attribute__((ext_vector_type(2)));
typedef _Float16 f16x4 __attribute__((ext_vector_type(4)));

constexpr int D = 1024, FF = 2816, NIN = 1536, GWID = 512, DEPTH = 4;
constexpr int SEQ = 2048, NB = 8, MP = NB * SEQ, MS = 128, MV = MP + MS, MPAD = 16640;
constexpr int NTHR = 512, NWAVES = 8;
constexpr int LDS_BYTES = 131072;
constexpr float LN_EPS = 1e-5f;
constexpr float ALPHA = 1.6817928305074292f;

constexpr size_t W_GU1 = 0, W_D1 = W_GU1 + (size_t)2 * FF * D, W_IN = W_D1 + (size_t)FF * D, W_OUT = W_IN + (size_t)NIN * D,
                 W_GU2 = W_OUT + (size_t)D * D, W_D2 = W_GU2 + (size_t)2 * FF * D, W_LAYER = W_D2 + (size_t)FF * D;
constexpr size_t WS_W = 0;
constexpr size_t WS_SMALL = WS_W + W_LAYER * 2 * DEPTH;
constexpr size_t SMALL_LAYER = 32768 * 2 + 65536;
constexpr size_t WS_X = WS_SMALL + SMALL_LAYER * 2 * DEPTH;
constexpr size_t WS_XN = WS_X + (size_t)MPAD * D * 4;
constexpr size_t WS_HP = WS_XN + (size_t)MPAD * D * 2;
constexpr size_t WS_MIX = WS_HP + (size_t)MPAD * NIN * 4;
constexpr size_t WS_AGG = WS_MIX + (size_t)MPAD * D * 2;
constexpr size_t WS_END = WS_AGG + (size_t)NB * 32 * 2 * 512 * 4;
static_assert((size_t)MPAD * FF * 2 <= (size_t)MPAD * NIN * 4, "hid fits in the proj region");
static_assert(WS_END <= 408000000ull, "workspace budget");

constexpr size_t O_Y = 0, O_PH = (size_t)MV * D, O_PC = O_PH + (size_t)DEPTH * NB * GWID, O_PP = O_PC + (size_t)DEPTH * NB * 3 * GWID,
                 O_SH = O_PP + (size_t)DEPTH * NB * 15 * GWID, O_SC = O_SH + (size_t)DEPTH * MS * GWID, O_SP = O_SC + (size_t)DEPTH * MS * 3 * GWID;

struct Params { const float* in[24]; float* out; unsigned char* ws; };
typedef const Params __attribute__((address_space(4))) CParams;
enum { I_XP = 0, I_XS, I_SH, I_SC, I_SP, I_LNG, I_LNB, I_W1G, I_W1U, I_W1D, I_WIN, I_CW, I_CB, I_GAW, I_GAB, I_GXW, I_GXB, I_LAM, I_PW, I_PS, I_WOUT, I_W2G, I_W2U, I_W2D };

__device__ __forceinline__ unsigned pk2(float lo, float hi) { return pg8::cvt_pk_bf16(lo, hi); }
__device__ __forceinline__ bf16_t f2bf(float f) { return (bf16_t)(pg8::cvt_pk_bf16(f, 0.f) & 0xffffu); }
__device__ __forceinline__ float wave_sum(float v) {
#pragma unroll
    for (int o = 1; o < 64; o <<= 1) v += __shfl_xor(v, o);
    return v;
}
__device__ __forceinline__ float sigmoidf_(float x) { return 1.0f / (1.0f + __expf(-x)); }
__device__ __forceinline__ float gelu_tanh(float x) {
    const float z = 0.7978845608028654f * (x + 0.044715f * x * x * x);
    const float e = __expf(2.0f * z);
    const float th = 1.0f - 2.0f / (e + 1.0f);
    return 0.5f * x * (1.0f + th);
}

struct EpiSwiglu {
    static constexpr bool PERM = true, AFTER_DRAIN = false;
    bf16_t* O; int ldc;
    __device__ __forceinline__ void operator()(const f32x4 (&acc)[2][2][4][2], const Unit& u, int wr, int wc, int fr, int fq) const {
        const int row0 = u.pm * BM + wr * 64 + fr, col0 = u.pn * 128 + wc * 32 + 8 * fq;
#pragma unroll
        for (int ai = 0; ai < 2; ++ai)
#pragma unroll
            for (int m = 0; m < 4; ++m) {
                bf16_t* rowp = O + (size_t)(row0 + ai * HALF + m * 16) * ldc + col0;
                float h[8];
#pragma unroll
                for (int n = 0; n < 2; ++n)
#pragma unroll
                    for (int j = 0; j < 4; ++j) { const float g = acc[ai][0][m][n][j], up = acc[ai][1][m][n][j]; h[n * 4 + j] = g * __builtin_amdgcn_rcpf(1.0f + __expf(-g)) * up; }
                u32x4 w; w.x = pk2(h[0], h[1]); w.y = pk2(h[2], h[3]); w.z = pk2(h[4], h[5]); w.w = pk2(h[6], h[7]);
                *(u32x4*)rowp = w;
            }
    }
};
struct EpiResid {
    static constexpr bool PERM = false, AFTER_DRAIN = false;
    float* X; int ldc; float alpha, coef;
    __device__ __forceinline__ void operator()(const f32x4 (&acc)[2][2][4][2], const Unit& u, int wr, int wc, int fr, int fq) const {
        const int row0 = u.pm * BM + wr * 64 + fr, col0 = u.pn * BM + wc * 32 + 4 * fq;
#pragma unroll
        for (int ai = 0; ai < 2; ++ai)
#pragma unroll
            for (int m = 0; m < 4; ++m) { float* rowp = X + (size_t)(row0 + ai * HALF + m * 16) * ldc + col0;
#pragma unroll
                for (int bj = 0; bj < 2; ++bj)
#pragma unroll
                    for (int n = 0; n < 2; ++n) { f32x4* p = (f32x4*)(rowp + bj * HALF + n * 16); const f32x4 v = *p; *p = v * alpha + acc[ai][bj][m][n] * coef; } }
    }
};

__device__ __forceinline__ void transpose_item(const float* W, int K, int N, bf16_t* WT, int mode, LAS float* scr, int item, int lane) {
    const int nblk = N / 32, kb = item / nblk, nb = item % nblk, k0 = 64 * kb, n0 = 32 * nb;
    const int drow0 = mode == 0 ? n0 : (256 * (n0 >> 7) + (n0 & 127) + (mode == 2 ? 128 : 0));
#pragma unroll 8
    for (int i = 0; i < 32; ++i) { const int kk = 2 * i + (lane >> 5); scr[kk * 33 + (lane & 31)] = W[(size_t)(k0 + kk) * N + n0 + (lane & 31)]; }
    asm volatile("s_waitcnt lgkmcnt(0)" ::: "memory");
    const int c = lane & 7;
#pragma unroll
    for (int j = 0; j < 4; ++j) { const int n = (lane >> 3) + 8 * j; const LAS float* s = scr + (8 * c) * 33 + n;
        u32x4 o; o.x = pk2(s[0 * 33], s[1 * 33]); o.y = pk2(s[2 * 33], s[3 * 33]); o.z = pk2(s[4 * 33], s[5 * 33]); o.w = pk2(s[6 * 33], s[7 * 33]);
        *(u32x4*)(WT + (size_t)(drow0 + n) * K + k0 + 8 * c) = o; }
    asm volatile("s_waitcnt lgkmcnt(0)" ::: "memory");
}
__device__ __forceinline__ void prologue(CParams* P, LAS unsigned char* lds, int gw, int NGW, int wave, int lane) {
    LAS float* scr = (LAS float*)(lds + wave * 16384);
    bf16_t* Wb = (bf16_t*)(P->ws + WS_W);
    constexpr int I_G = (D / 64) * (FF / 32), I_DN = (FF / 64) * (D / 32), I_I = (D / 64) * (NIN / 32), I_O = (D / 64) * (D / 32);
    constexpr int PER_LAYER = 4 * I_G + 2 * I_DN + I_I + I_O;
    for (int it = gw; it < PER_LAYER * DEPTH; it += NGW) {
        const int l = it / PER_LAYER; int r = it % PER_LAYER; bf16_t* WL = Wb + (size_t)l * W_LAYER;
        if (r < I_G) { transpose_item(P->in[I_W1G] + (size_t)l * D * FF, D, FF, WL + W_GU1, 1, scr, r, lane); continue; } r -= I_G;
        if (r < I_G) { transpose_item(P->in[I_W1U] + (size_t)l * D * FF, D, FF, WL + W_GU1, 2, scr, r, lane); continue; } r -= I_G;
        if (r < I_DN) { transpose_item(P->in[I_W1D] + (size_t)l * D * FF, FF, D, WL + W_D1, 0, scr, r, lane); continue; } r -= I_DN;
        if (r < I_I) { transpose_item(P->in[I_WIN] + (size_t)l * D * NIN, D, NIN, WL + W_IN, 0, scr, r, lane); continue; } r -= I_I;
        if (r < I_O) { transpose_item(P->in[I_WOUT] + (size_t)l * D * D, D, D, WL + W_OUT, 0, scr, r, lane); continue; } r -= I_O;
        if (r < I_G) { transpose_item(P->in[I_W2G] + (size_t)l * D * FF, D, FF, WL + W_GU2, 1, scr, r, lane); continue; } r -= I_G;
        if (r < I_G) { transpose_item(P->in[I_W2U] + (size_t)l * D * FF, D, FF, WL + W_GU2, 2, scr, r, lane); continue; } r -= I_G;
        transpose_item(P->in[I_W2D] + (size_t)l * D * FF, FF, D, WL + W_D2, 0, scr, r, lane);
    }
    bf16_t* Sm = (bf16_t*)(P->ws + WS_SMALL);
    const int gt = gw * 64 + lane, NGT = NGW * 64;
    for (int o = gt; o < DEPTH * 32768; o += NGT) {
        const int l = o / 32768, rem = o % 32768, h = rem / 4096, j = (rem / 64) % 64, i = rem % 64;
        const size_t src = (size_t)l * 32768 + h * 4096 + i * 64 + j;
        Sm[(size_t)l * SMALL_LAYER + rem] = f2bf(P->in[I_GAW][src]);
        Sm[(size_t)l * SMALL_LAYER + 32768 + rem] = f2bf(P->in[I_GXW][src]);
    }
    for (int o = gt; o < DEPTH * 65536; o += NGT) {
        const int l = o / 65536, rem = o % 65536, g = rem / 16384, j = (rem / 128) % 128, i = rem % 128;
        Sm[(size_t)l * SMALL_LAYER + 65536 + rem] = f2bf(P->in[I_PW][(size_t)l * 65536 + g * 16384 + i * 128 + j]);
    }
    float* X = (float*)(P->ws + WS_X); bf16_t* XN = (bf16_t*)(P->ws + WS_XN);
    for (int m = gw; m < MV; m += NGW) {
        const float* src = m < MP ? P->in[I_XP] + (size_t)m * D : P->in[I_XS] + (size_t)(m - MP) * D;
        const f32x4* xr = (const f32x4*)src + lane; f32x4* xo = (f32x4*)(X + (size_t)m * D) + lane; u32x2* o8 = (u32x2*)(XN + (size_t)m * D) + lane;
#pragma unroll
        for (int j = 0; j < 4; ++j) { const f32x4 v = xr[64 * j]; xo[64 * j] = v; u32x2 w; w.x = pk2(v[0], v[1]); w.y = pk2(v[2], v[3]); o8[64 * j] = w; }
    }
}

__device__ __forceinline__ void ln_pass(float* X, bf16_t* XN, float* OUT, const float* g, const float* b, int gw, int NGW, int lane) {
    f32x4 gg[4], bb[4];
#pragma unroll
    for (int j = 0; j < 4; ++j) { gg[j] = ((const f32x4*)g)[lane + 64 * j]; bb[j] = ((const f32x4*)b)[lane + 64 * j]; }
    for (int m = gw; m < MV; m += NGW) {
        const f32x4* xr = (const f32x4*)(X + (size_t)m * D) + lane;
        f32x4 v[4]; float s = 0.f;
#pragma unroll
        for (int j = 0; j < 4; ++j) { v[j] = xr[64 * j]; s += (v[j][0] + v[j][1]) + (v[j][2] + v[j][3]); }
        const float mean = wave_sum(s) * (1.f / D); float s2 = 0.f;
#pragma unroll
        for (int j = 0; j < 4; ++j) { v[j] = v[j] - mean; s2 += (v[j][0] * v[j][0] + v[j][1] * v[j][1]) + (v[j][2] * v[j][2] + v[j][3] * v[j][3]); }
        const float rstd = 1.0f / sqrtf(wave_sum(s2) * (1.f / D) + LN_EPS);
        f32x4* xo = (f32x4*)((OUT ? OUT : X) + (size_t)m * D) + lane; u32x2* o8 = (u32x2*)(XN + (size_t)m * D) + lane;
#pragma unroll
        for (int j = 0; j < 4; ++j) { const f32x4 y = v[j] * rstd * gg[j] + bb[j]; xo[64 * j] = y; u32x2 w; w.x = pk2(y[0], y[1]); w.y = pk2(y[2], y[3]); o8[64 * j] = w; }
    }
}

constexpr int XCS = 520;
constexpr int XC_OFF = 0, R_OFF = 32 * XCS * 2, I_OFF = 2 * 32 * XCS * 2;

__device__ __forceinline__ void gates_mfma(LAS unsigned char* lds, const bf16_t* WaT, const bf16_t* WxT, const float* ba, const float* bx, int h, int fr, int fq) {
    bf16x8 A[2][2];
#pragma unroll
    for (int mb = 0; mb < 2; ++mb)
#pragma unroll
        for (int kb = 0; kb < 2; ++kb) A[mb][kb] = *(const LAS bf16x8*)(lds + XC_OFF + ((mb * 16 + fr) * XCS + 64 * h + kb * 32 + 8 * fq) * 2);
#pragma unroll
    for (int gate = 0; gate < 2; ++gate) {
        const bf16_t* W = (gate ? WxT : WaT) + h * 4096; const float* bias = (gate ? bx : ba) + 64 * h; const int ooff = gate ? I_OFF : R_OFF;
#pragma unroll
        for (int nb = 0; nb < 4; ++nb) {
            const bf16x8 B0 = *(const bf16x8*)(W + (nb * 16 + fr) * 64 + 8 * fq), B1 = *(const bf16x8*)(W + (nb * 16 + fr) * 64 + 32 + 8 * fq);
            const f32x4 bv = *(const f32x4*)(bias + nb * 16 + 4 * fq);
#pragma unroll
            for (int mb = 0; mb < 2; ++mb) {
                f32x4 acc = (f32x4){0.f, 0.f, 0.f, 0.f};
                acc = __builtin_amdgcn_mfma_f32_16x16x32_bf16(B0, A[mb][0], acc, 0, 0, 0);
                acc = __builtin_amdgcn_mfma_f32_16x16x32_bf16(B1, A[mb][1], acc, 0, 0, 0);
                acc = acc + bv;
                f16x4 hv; hv[0] = (_Float16)sigmoidf_(acc[0]); hv[1] = (_Float16)sigmoidf_(acc[1]); hv[2] = (_Float16)sigmoidf_(acc[2]); hv[3] = (_Float16)sigmoidf_(acc[3]);
                *(LAS f16x4*)(lds + ooff + ((mb * 16 + fr) * XCS + 64 * h + nb * 16 + 4 * fq) * 2) = hv;
            }
        }
    }
}
__device__ __forceinline__ void pool_mfma(LAS unsigned char* lds, const bf16_t* PWT, const float* pscale, bf16_t* mixrow, int w, int fr, int fq) {
    const int g = w >> 1, half = w & 1;
    f32x4 acc[4][4];
#pragma unroll
    for (int mb = 0; mb < 4; ++mb)
#pragma unroll
        for (int nb = 0; nb < 4; ++nb) acc[mb][nb] = (f32x4){0.f, 0.f, 0.f, 0.f};
#pragma unroll
    for (int kb = 0; kb < 4; ++kb) {
        bf16x8 A[4];
#pragma unroll
        for (int mb = 0; mb < 4; ++mb) A[mb] = *(const LAS bf16x8*)(lds + ((mb * 16 + fr) * XCS + 128 * g + kb * 32 + 8 * fq) * 2);
#pragma unroll
        for (int nb = 0; nb < 4; ++nb) {
            const bf16x8 B = *(const bf16x8*)(PWT + ((size_t)g * 128 + 64 * half + nb * 16 + fr) * 128 + kb * 32 + 8 * fq);
#pragma unroll
            for (int mb = 0; mb < 4; ++mb) acc[mb][nb] = __builtin_amdgcn_mfma_f32_16x16x32_bf16(B, A[mb], acc[mb][nb], 0, 0, 0);
        }
    }
#pragma unroll
    for (int nb = 0; nb < 4; ++nb) {
        const int ch = 128 * g + 64 * half + nb * 16 + 4 * fq; const f32x4 sc = *(const f32x4*)(pscale + ch);
#pragma unroll
        for (int mb = 0; mb < 4; ++mb) { const f32x4 v = acc[mb][nb] * sc; u32x2 o; o.x = pk2(v[0], v[1]); o.y = pk2(v[2], v[3]);
            *(u32x2*)(mixrow + (size_t)(mb * 16 + fr) * D + GWID + ch) = o; }
    }
}
__device__ __forceinline__ void pool_prompt_thread(const float* UP, int t0, int W, LAS bf16_t* PL, int c) {
    float s = 0.f;
    if (t0 > 0) for (int k = 1; k < W; ++k) s += UP[-k * NIN];
#pragma unroll 8
    for (int t = 0; t < 64; ++t) {
        const float v = UP[t * NIN]; s += v;
        const float cnt = fminf((float)W, (float)(t0 + t + 1)); PL[t * XCS + c] = f2bf(s / cnt - v);
        const float old = (t0 + t - W + 1 >= 0) ? UP[(t - W + 1) * NIN] : 0.f; s -= old;
    }
}
__device__ __forceinline__ void pool_sample_thread(const float* UP  , const float* SPs  , float* SPo, int W, LAS bf16_t* PL, int c) {
#pragma unroll 2
    for (int t = 0; t < 64; ++t) {
        const float v = UP[(size_t)t * NIN]; float s = v;
        const float* sp = SPs + (size_t)t * 15 * GWID; float* so = SPo + (size_t)t * 15 * GWID;
#pragma unroll
        for (int k = 0; k < 15; ++k) { const float q = sp[k * GWID]; if (k >= 16 - W) s += q; if (k >= 1) so[(k - 1) * GWID] = q; }
        so[14 * GWID] = v;
        PL[t * XCS + c] = f2bf(s / (float)W - v);
    }
}

struct MixW {
    const float *cw, *cb, *gab, *gxb, *lam, *psc; const bf16_t *GAT, *GXT, *PWT;
};

__global__ void __launch_bounds__(NTHR, 2) fwd_megakernel(Params p) {
    extern __shared__ __attribute__((aligned(16))) unsigned char lds_raw[];
    LAS unsigned char* lds = (LAS unsigned char*)lds_raw;
    cg::grid_group grid = cg::this_grid();
    const int G = gridDim.x, bid = blockIdx.x, NGW = G * NWAVES;

    { const int tid = threadIdx.x, lane = tid & 63, wave = __builtin_amdgcn_readfirstlane(tid >> 6);
      prologue((CParams*)__builtin_amdgcn_kernarg_segment_ptr(), lds, bid * NWAVES + wave, NGW, wave, lane); }
    grid.sync();

    constexpr int NK = 10;
    for (int ph = 0; ph < DEPTH * NK; ++ph) {
        const int l = ph / NK, kind = ph % NK;
        int tid = threadIdx.x; asm volatile("" : "+v"(tid));
        const int lane = tid & 63, wave = __builtin_amdgcn_readfirstlane(tid >> 6), fr = lane & 15, fq = lane >> 4, gw = bid * NWAVES + wave;
        CParams* P = (CParams*)__builtin_amdgcn_kernarg_segment_ptr(); asm volatile("" : "+s"(P));
        unsigned char* const ws = P->ws;
        float* X = (float*)(ws + WS_X); bf16_t* XN = (bf16_t*)(ws + WS_XN); bf16_t* HID = (bf16_t*)(ws + WS_HP); float* PROJ = (float*)(ws + WS_HP);
        bf16_t* MIX = (bf16_t*)(ws + WS_MIX); float* AGG = (float*)(ws + WS_AGG);
        const bf16_t* Wb = (const bf16_t*)(ws + WS_W); const bf16_t* Sm = (const bf16_t*)(ws + WS_SMALL);
        const bf16_t* WL = Wb + (size_t)l * W_LAYER;
        if (kind == 0 || kind == 7) {
            pg8::Gemm g{XN, WL + (kind == 0 ? W_GU1 : W_GU2), MPAD, 2 * FF, D}; pg8::StaticOrder S; S.init(MPAD, 2 * FF, G, bid);
            EpiSwiglu E{HID, FF};
            pg8::gemm_phase<EpiSwiglu, pg8::StaticOrder>(lds, g, S, E, nullptr);
        } else if (kind == 1 || kind == 8 || kind == 5) {
            const bool wo = (kind == 5);
            pg8::Gemm g{wo ? MIX : HID, WL + (wo ? W_OUT : (kind == 1 ? W_D1 : W_D2)), MPAD, D, wo ? D : FF}; pg8::StaticOrder S; S.init(MPAD, D, G, bid);
            EpiResid E{X, D, ALPHA, wo ? 1.0f : 0.5f};
            pg8::gemm_phase<EpiResid, pg8::StaticOrder>(lds, g, S, E, nullptr);
        } else if (kind == 3) {
            pg8::Gemm g{XN, WL + W_IN, MPAD, NIN, D}; pg8::StaticOrder S; S.init(MPAD, NIN, G, bid);
            pg8::EpiF32 E{PROJ, NIN, nullptr};
            pg8::gemm_phase<pg8::EpiF32, pg8::StaticOrder>(lds, g, S, E, nullptr);
        } else if (kind == 2 || kind == 6 || kind == 9) {
            const int which = kind == 2 ? 0 : (kind == 6 ? 1 : 2);
            const bool fin = (l == DEPTH - 1 && which == 2);
            ln_pass(X, XN, fin ? P->out + O_Y : nullptr, P->in[I_LNG] + (size_t)(l * 3 + which) * D, P->in[I_LNB] + (size_t)(l * 3 + which) * D, gw, NGW, lane);
        } else {
            MixW mw; mw.cw = P->in[I_CW] + (size_t)l * 4 * GWID; mw.cb = P->in[I_CB] + (size_t)l * GWID; mw.gab = P->in[I_GAB] + (size_t)l * GWID; mw.gxb = P->in[I_GXB] + (size_t)l * GWID;
            mw.lam = P->in[I_LAM] + (size_t)l * GWID; mw.psc = P->in[I_PS] + (size_t)l * GWID;
            mw.GAT = Sm + (size_t)l * SMALL_LAYER; mw.GXT = mw.GAT + 32768; mw.PWT = mw.GAT + 65536;
            const int c = tid;
            const bool has = bid < NB * 32;
            const int b = bid >> 5, j = bid & 31, t0 = j * 64; const size_t row0 = (size_t)b * SEQ + t0;
            const float cw0 = mw.cw[c], cw1 = mw.cw[GWID + c], cw2 = mw.cw[2 * GWID + c], cw3 = mw.cw[3 * GWID + c], cbv = mw.cb[c];
            const float lamv = mw.lam[c]; const float k8 = -8.0f * log1pf(__expf(-lamv));
            if (has) {
                {
                    const float* UP = PROJ + row0 * NIN + 2 * GWID + c; LAS bf16_t* PL = (LAS bf16_t*)lds;
                    pool_prompt_thread(UP, t0, 2 << (wave >> 1), PL, c);
                    if (j == 31) { float* o = P->out + O_PP + ((size_t)(l * NB + b) * 15) * GWID + c;
#pragma unroll
                        for (int k = 0; k < 15; ++k) o[k * GWID] = UP[(49 + k) * NIN]; }
                    __syncthreads();
                    pool_mfma(lds, mw.PWT, mw.psc, MIX + row0 * D, wave, fr, fq);
                    __syncthreads();
                }
            }
            for (int pass = 0; pass < 2; ++pass) {
                if (has) {
                    float h = 0.f, cum = 1.f;
                    if (pass == 1) for (int i = 0; i < j; ++i) { const float A_ = AGG[((size_t)(b * 32 + i) * 2 + 0) * GWID + c], H_ = AGG[((size_t)(b * 32 + i) * 2 + 1) * GWID + c]; h = A_ * h + H_; }
                    const float* U = PROJ + row0 * NIN + c; bf16_t* mo = MIX + row0 * D + c;
                    float p0 = 0.f, p1 = 0.f, p2 = 0.f;
                    if (j > 0) { p0 = U[-3 * NIN]; p1 = U[-2 * NIN]; p2 = U[-1 * NIN]; }
                    for (int s = 0; s < 2; ++s) {
                        float xc[32];
#pragma unroll
                        for (int t = 0; t < 32; ++t) { const float v = U[(s * 32 + t) * NIN]; xc[t] = cbv + cw0 * p0 + cw1 * p1 + cw2 * p2 + cw3 * v; p0 = p1; p1 = p2; p2 = v;
                            ((LAS bf16_t*)(lds + XC_OFF))[t * XCS + c] = f2bf(xc[t]); if ((t & 7) == 7) asm volatile("" ::: "memory"); }
                        __syncthreads();
                        gates_mfma(lds, mw.GAT, mw.GXT, mw.gab, mw.gxb, wave, fr, fq);
                        __syncthreads();
#pragma unroll
                        for (int t = 0; t < 32; ++t) {
                            const float r = (float)((const LAS _Float16*)(lds + R_OFF))[t * XCS + c], ig = (float)((const LAS _Float16*)(lds + I_OFF))[t * XCS + c];
                            const float la = r * k8, a = __expf(la), mult = sqrtf(-expm1f(2.0f * la)), uu = mult * (ig * xc[t]);
                            h = a * h + uu; cum *= a;
                            if (pass == 1) mo[(size_t)(s * 32 + t) * D] = f2bf(h * gelu_tanh(U[(s * 32 + t) * NIN + GWID]));
                            if ((t & 7) == 7) asm volatile("" ::: "memory");
                        }
                        __syncthreads();
                    }
                    if (pass == 0) {
                        AGG[((size_t)(b * 32 + j) * 2 + 0) * GWID + c] = cum; AGG[((size_t)(b * 32 + j) * 2 + 1) * GWID + c] = h;
                        if (j == 31) { float* o = P->out + O_PC + ((size_t)(l * NB + b) * 3) * GWID + c; o[0] = p0; o[GWID] = p1; o[2 * GWID] = p2; }
                    } else if (j == 31) P->out[O_PH + (size_t)(l * NB + b) * GWID + c] = h;
                }
                if (pass == 0) grid.sync();
            }
            if (bid >= G - 2) {
                const int b0 = (bid - (G - 2)) * 64; const size_t srow0 = (size_t)MP + b0;
                __syncthreads();
                {
                    const float* UP = PROJ + srow0 * NIN + 2 * GWID + c; LAS bf16_t* PL = (LAS bf16_t*)lds;
                    const float* SPs = P->in[I_SP] + ((size_t)(l * MS + b0) * 15) * GWID + c; float* SPo = P->out + O_SP + ((size_t)(l * MS + b0) * 15) * GWID + c;
                    pool_sample_thread(UP, SPs, SPo, 2 << (wave >> 1), PL, c);
                    __syncthreads();
                    pool_mfma(lds, mw.PWT, mw.psc, MIX + srow0 * D, wave, fr, fq);
                    __syncthreads();
                }
                for (int s = 0; s < 2; ++s) {
                    const size_t r0 = srow0 + s * 32; const int bb0 = b0 + s * 32;
                    float xc[32];
#pragma unroll
                    for (int t = 0; t < 32; ++t) {
                        const float v = PROJ[(r0 + t) * NIN + c]; const float* sc = P->in[I_SC] + ((size_t)(l * MS + bb0 + t) * 3) * GWID + c;
                        const float s0 = sc[0], s1 = sc[GWID], s2 = sc[2 * GWID];
                        xc[t] = cbv + cw0 * s0 + cw1 * s1 + cw2 * s2 + cw3 * v;
                        float* so = P->out + O_SC + ((size_t)(l * MS + bb0 + t) * 3) * GWID + c; so[0] = s1; so[GWID] = s2; so[2 * GWID] = v;
                        ((LAS bf16_t*)(lds + XC_OFF))[t * XCS + c] = f2bf(xc[t]);
                        if ((t & 3) == 3) asm volatile("" ::: "memory");
                    }
                    __syncthreads();
                    gates_mfma(lds, mw.GAT, mw.GXT, mw.gab, mw.gxb, wave, fr, fq);
                    __syncthreads();
#pragma unroll
                    for (int t = 0; t < 32; ++t) {
                        const float r = (float)((const LAS _Float16*)(lds + R_OFF))[t * XCS + c], ig = (float)((const LAS _Float16*)(lds + I_OFF))[t * XCS + c];
                        const float la = r * k8, a = __expf(la), mult = sqrtf(-expm1f(2.0f * la)), uu = mult * (ig * xc[t]);
                        const float h0 = P->in[I_SH][(size_t)(l * MS + bb0 + t) * GWID + c];
                        const float hh = a * h0 + uu;
                        P->out[O_SH + (size_t)(l * MS + bb0 + t) * GWID + c] = hh;
                        MIX[(r0 + t) * D + c] = f2bf(hh * gelu_tanh(PROJ[(r0 + t) * NIN + GWID + c]));
                        if ((t & 3) == 3) asm volatile("" ::: "memory");
                    }
                    __syncthreads();
                }
            }
        }
        if (ph != DEPTH * NK - 1) grid.sync();
    }
}

extern "C" void kernel_launch(void* const* d_in, const int* in_sizes, int n_in, void* d_out, int out_size, void* d_ws, size_t ws_size, hipStream_t stream) {
    static int grid_blocks = 0;
    if (!grid_blocks) {
        int dev = 0, cus = 0, per_cu = 0;
        hipGetDevice(&dev);
        hipDeviceGetAttribute(&cus, hipDeviceAttributeMultiprocessorCount, dev);
        hipFuncSetAttribute((const void*)fwd_megakernel, hipFuncAttributeMaxDynamicSharedMemorySize, LDS_BYTES);
        hipOccupancyMaxActiveBlocksPerMultiprocessor(&per_cu, (const void*)fwd_megakernel, NTHR, LDS_BYTES);
        if (per_cu < 1) per_cu = 1;
        grid_blocks = cus * per_cu;
        if (grid_blocks > 256) grid_blocks = 256;
        if (ws_size < WS_END) fprintf(stderr, "kernel_launch: workspace too small: %zu < %zu\n", ws_size, (size_t)WS_END);
    }
    Params p{};
    for (int i = 0; i < 24; ++i) p.in[i] = (const float*)d_in[i];
    p.out = (float*)d_out; p.ws = (unsigned char*)d_ws;
    void* args[] = {&p};
    hipError_t e = hipLaunchCooperativeKernel((const void*)fwd_megakernel, dim3(grid_blocks), dim3(NTHR), args, LDS_BYTES, stream);
    if (e != hipSuccess) fprintf(stderr, "cooperative launch failed: %s (grid %d)\n", hipGetErrorString(e), grid_blocks);
}
```

```cpp
#include <hip/hip_runtime.h>
#include <hip/hip_cooperative_groups.h>
#include <cstdio>
namespace cg = cooperative_groups;
namespace pg8 {
#define PG8_LAS __attribute__((address_space(3)))
typedef unsigned short bf16_t;
typedef short bf16x8 __attribute__((ext_vector_type(8)));
typedef float f32x4 __attribute__((ext_vector_type(4)));
typedef unsigned u32x4 __attribute__((ext_vector_type(4)));
constexpr int BM = 256, BK = 64, HALF = 128, HTB = HALF * BK * 2  , STAGE_BYTES = 8 * HTB, NXCD = 8, WGM = 8;

__host__ __device__ __forceinline__ int lds_byte(int r, int c) { const int st = (r >> 4) * 2 + (c >> 5), rr = r & 15, cc = c & 31, ob = rr * 64 + cc * 2; return st * 1024 + (ob ^ (((ob >> 9) & 1) << 5)); }
__host__ __device__ __forceinline__ void stage_rc(int b, int& R, int& C) { const int st = b / 1024, sb = b % 1024, swz = sb ^ (((sb >> 9) & 1) << 5); R = (st >> 1) * 16 + swz / 64; C = (st & 1) * 32 + (swz % 64) / 2; }
__host__ __device__ __forceinline__ int perm32(int rho) { const int n = rho >> 4, i = rho & 15; return 8 * (i >> 2) + 4 * n + (i & 3); }

struct Unit { int pm, pn; };
struct Gemm { const bf16_t* A; const bf16_t* Bt; int M, N, K; };

struct StaticOrder {
    int nM, nN, nwg, G, c;
    __host__ __device__ void init(int M, int N, int G_, int c_) { nM = M / BM; nN = N / BM; nwg = nM * nN; G = G_; c = c_; }
    __host__ __device__ bool next(int i, Unit& u) const {
        const long L = (long)i * G + c; if (L >= nwg) return false;
        int wgid = (int)L; { const int q = nwg / NXCD, r = nwg % NXCD, xcd = wgid % NXCD, off = wgid / NXCD; wgid = (xcd < r ? xcd * (q + 1) : r * (q + 1) + (xcd - r) * q) + off; }
        const int nig = WGM * nN, gid = wgid / nig, fm = gid * WGM, gsz = (nM - fm) < WGM ? (nM - fm) : WGM;
        u.pm = fm + ((wgid % nig) % gsz); u.pn = (wgid % nig) / gsz; return true;
    }
    __device__ __forceinline__ void a_ready(const Unit&) const {}
    __device__ __forceinline__ void done(const Unit&) const {}
};
__device__ __forceinline__ unsigned cvt_pk_bf16(float lo, float hi) { unsigned r; asm volatile("v_cvt_pk_bf16_f32 %0, %1, %2" : "=v"(r) : "v"(lo), "v"(hi)); return r; }
typedef float f32x2 __attribute__((ext_vector_type(2)));
struct EpiF32 {
    static constexpr bool PERM = false, AFTER_DRAIN = false;
    float* C; int ldc; const float* bias;
    __device__ __forceinline__ void operator()(const f32x4 (&acc)[2][2][4][2], const Unit& u, int wr, int wc, int fr, int fq) const {
        const int row0 = u.pm * BM + wr * 64 + fr, col0 = u.pn * BM + wc * 32 + 4 * fq;
        f32x4 bv[2][2];
#pragma unroll
        for (int bj = 0; bj < 2; ++bj)
#pragma unroll
            for (int n = 0; n < 2; ++n) bv[bj][n] = bias ? *(const f32x4*)(bias + col0 + bj * HALF + n * 16) : (f32x4){0.f, 0.f, 0.f, 0.f};
#pragma unroll
        for (int ai = 0; ai < 2; ++ai)
#pragma unroll
            for (int m = 0; m < 4; ++m) { float* rowp = C + (size_t)(row0 + ai * HALF + m * 16) * ldc + col0;
#pragma unroll
                for (int bj = 0; bj < 2; ++bj)
#pragma unroll
                    for (int n = 0; n < 2; ++n) *(f32x4*)(rowp + bj * HALF + n * 16) = acc[ai][bj][m][n] + bv[bj][n]; }
    }
};
template <class Epi, class Sched, bool STAMP = false>
__device__ __forceinline__ void gemm_phase(PG8_LAS unsigned char* lds, const Gemm g, const Sched& S, const Epi& E, unsigned long long* stamps) {
    int tid_l = threadIdx.x; asm volatile("" : "+v"(tid_l));
    const int tid = tid_l, wid = __builtin_amdgcn_readfirstlane(tid >> 6), lane = tid & 63, wr = wid >> 2, wc = wid & 3, fr = lane & 15, fq = lane >> 4;
    const int K = g.K, nt = K / BK;
    int ts_lo = 0, ts_hi = 0, nts = 0; const unsigned long long rt_entry = STAMP ? (unsigned long long)wall_clock64() : 0ull;
#define PG8_STAMP() do { if (STAMP && wid == 0 && nts < 64) { const unsigned long long _c = (unsigned long long)clock64(); \
        ts_lo = (lane == nts) ? (int)(unsigned)_c : ts_lo; ts_hi = (lane == nts) ? (int)(unsigned)(_c >> 32) : ts_hi; ++nts; } } while (0)
    PG8_STAMP();
    unsigned voffA[2], voffB[2];
#pragma unroll
    for (int i = 0; i < 2; ++i) { int R, C; stage_rc(tid * 16 + i * 8192, R, C); const int Rb = Epi::PERM ? ((R & ~31) + perm32(R & 31)) : R;
        voffA[i] = (unsigned)(R * K + C) * 2u; voffB[i] = (unsigned)(Rb * K + C) * 2u; }
    const size_t kstep = (size_t)(BK * 2);
    const size_t hstep = (size_t)HALF * K * 2;
    const size_t tstep = 2 * hstep;
    const unsigned ldsw = (unsigned)wid * 1024u;
    const int aoff = lds_byte(wr * 64 + fr, fq * 8), boff = lds_byte(wc * 32 + fr, fq * 8);
#define PG8_SA(b, h) (((b) * 2 + (h)) * HTB)
#define PG8_SB(b, h) ((4 + (b) * 2 + (h)) * HTB)
#define PG8_STAGE(bufoff, gbase, voff) do { _Pragma("unroll") for (int _i = 0; _i < 2; ++_i) \
        __builtin_amdgcn_global_load_lds((const unsigned*)((const char*)(gbase) + (voff)[_i]), (PG8_LAS unsigned*)(lds + (bufoff) + ldsw + _i * 8192), 16, 0, 0); } while (0)
#define PG8_LDA(dst, b, h) do { _Pragma("unroll") for (int m = 0; m < 4; ++m) _Pragma("unroll") for (int k = 0; k < 2; ++k) dst[m][k] = *(const PG8_LAS bf16x8*)(lds + PG8_SA(b, h) + aoff + m * 2048 + k * 1024); } while (0)
#define PG8_LDB(dst, b, h) do { _Pragma("unroll") for (int n = 0; n < 2; ++n) _Pragma("unroll") for (int k = 0; k < 2; ++k) dst[n][k] = *(const PG8_LAS bf16x8*)(lds + PG8_SB(b, h) + boff + n * 2048 + k * 1024); } while (0)
#define PG8_MMA(ai, bj, At, Bt) do { __builtin_amdgcn_s_setprio(1); _Pragma("unroll") for (int m = 0; m < 4; ++m) _Pragma("unroll") for (int n = 0; n < 2; ++n) _Pragma("unroll") for (int k = 0; k < 2; ++k) \
        acc[ai][bj][m][n] = __builtin_amdgcn_mfma_f32_16x16x32_bf16(Bt[n][k], At[m][k], acc[ai][bj][m][n], 0, 0, 0); __builtin_amdgcn_s_setprio(0); } while (0)
#define PG8_WAIT_V(n) asm volatile("s_waitcnt vmcnt(" #n ")" ::: "memory")
#define PG8_WAIT_L(n) asm volatile("s_waitcnt lgkmcnt(" #n ")" ::: "memory")
#define PG8_BAR __builtin_amdgcn_s_barrier()
#define PG8_SCHED __builtin_amdgcn_sched_barrier(0)
    Unit cur, nxt; int ui = 0;
    if (!S.next(0, cur)) return;
    f32x4 acc[2][2][4][2];
#pragma unroll
    for (int a = 0; a < 2; ++a)
#pragma unroll
        for (int b = 0; b < 2; ++b)
#pragma unroll
            for (int m = 0; m < 4; ++m)
#pragma unroll
                for (int n = 0; n < 2; ++n) acc[a][b][m][n] = (f32x4){0.f, 0.f, 0.f, 0.f};
    bf16x8 At[4][2], B0[2][2], B1[2][2];
    const char* cA = (const char*)g.A + (size_t)cur.pm * tstep; const char* cB = (const char*)g.Bt + (size_t)cur.pn * tstep;
    S.a_ready(cur);
    PG8_STAGE(PG8_SB(0, 0), cB, voffB); PG8_STAGE(PG8_SA(0, 0), cA, voffA); PG8_STAGE(PG8_SB(0, 1), cB + hstep, voffB); PG8_STAGE(PG8_SA(0, 1), cA + hstep, voffA);
    if (wr == 1) PG8_BAR;
    PG8_WAIT_V(4); PG8_BAR;
    PG8_STAGE(PG8_SB(1, 0), cB + kstep, voffB); PG8_STAGE(PG8_SA(1, 0), cA + kstep, voffA); PG8_STAGE(PG8_SB(1, 1), cB + hstep + kstep, voffB);
    PG8_WAIT_V(6); PG8_BAR;
    PG8_STAMP();
    for (;;) {
        const bool has_next = S.next(ui + 1, nxt);
        const char* nA = has_next ? (const char*)g.A + (size_t)nxt.pm * tstep : cA; const char* nB = has_next ? (const char*)g.Bt + (size_t)nxt.pn * tstep : cB;
        for (int t = 0; t < nt; t += 2) {
            const bool last = (t == nt - 2);
            const char* a1 = cA + (size_t)(t + 1) * kstep;
            const char* a2 = last ? nA : cA + (size_t)(t + 2) * kstep; const char* b2 = last ? nB : cB + (size_t)(t + 2) * kstep;
            const char* a3 = a2 + kstep; const char* b3 = b2 + kstep;
            if (last && has_next) S.a_ready(nxt);
            PG8_LDB(B0, 0, 0); PG8_SCHED; PG8_LDA(At, 0, 0); PG8_STAGE(PG8_SA(1, 1), a1 + hstep, voffA);
            PG8_WAIT_L(8); PG8_BAR; PG8_WAIT_L(0); PG8_MMA(0, 0, At, B0); PG8_BAR; PG8_SCHED;
            PG8_LDB(B1, 0, 1); PG8_STAGE(PG8_SB(0, 0), b2, voffB);
            PG8_BAR; PG8_WAIT_L(0); PG8_MMA(0, 1, At, B1); PG8_BAR;
            PG8_LDA(At, 0, 1); PG8_STAGE(PG8_SA(0, 0), a2, voffA);
            PG8_BAR; PG8_WAIT_L(0); PG8_MMA(1, 0, At, B0); PG8_BAR; PG8_SCHED;
            PG8_STAGE(PG8_SB(0, 1), b2 + hstep, voffB);
            PG8_WAIT_V(6); PG8_BAR; PG8_MMA(1, 1, At, B1); PG8_BAR;
            PG8_LDB(B0, 1, 0); PG8_SCHED; PG8_LDA(At, 1, 0); PG8_STAGE(PG8_SA(0, 1), a2 + hstep, voffA);
            PG8_WAIT_L(8); PG8_BAR; PG8_WAIT_L(0); PG8_MMA(0, 0, At, B0); PG8_BAR; PG8_SCHED;
            PG8_LDB(B1, 1, 1); PG8_STAGE(PG8_SB(1, 0), b3, voffB);
            PG8_BAR; PG8_WAIT_L(0); PG8_MMA(0, 1, At, B1); PG8_BAR;
            PG8_LDA(At, 1, 1); PG8_STAGE(PG8_SA(1, 0), a3, voffA);
            PG8_BAR; PG8_WAIT_L(0); PG8_MMA(1, 0, At, B0); PG8_BAR; PG8_SCHED;
            PG8_STAGE(PG8_SB(1, 1), b3 + hstep, voffB);
            PG8_WAIT_V(6); PG8_BAR; PG8_MMA(1, 1, At, B1); PG8_BAR;
        }
        PG8_STAMP();
        if constexpr (!Epi::AFTER_DRAIN) { E(acc, cur, wr, wc, fr, fq); S.done(cur); }
        PG8_STAMP();
        if (!has_next) break;
#pragma unroll
        for (int a = 0; a < 2; ++a)
#pragma unroll
            for (int b = 0; b < 2; ++b)
#pragma unroll
                for (int m = 0; m < 4; ++m)
#pragma unroll
                    for (int n = 0; n < 2; ++n) acc[a][b][m][n] = (f32x4){0.f, 0.f, 0.f, 0.f};
        cur = nxt; cA = nA; cB = nB; ++ui;
    }
    PG8_WAIT_V(0);
    if (wr == 0) PG8_BAR;
    PG8_BAR;
    if constexpr (Epi::AFTER_DRAIN) { E.fused(acc, cur, wr, wc, fr, fq, lds, wid, lane); S.done(cur); }
    PG8_STAMP();
    if (STAMP && wid == 0) { stamps[lane] = lane < nts ? (((unsigned long long)(unsigned)ts_hi << 32) | (unsigned)ts_lo) : 0ull;
        if (lane == 62) stamps[62] = rt_entry; if (lane == 63) stamps[63] = (unsigned long long)wall_clock64(); }
#undef PG8_STAMP
#undef PG8_SA
#undef PG8_SB
#undef PG8_STAGE
#undef PG8_LDA
#undef PG8_LDB
#undef PG8_MMA
#undef PG8_WAIT_V
#undef PG8_WAIT_L
#undef PG8_BAR
#undef PG8_SCHED
}
}
#define LAS __attribute__((address_space(3)))
#define XB_TMO      128
#define XB_XCNT(j)  (256  + 64 * (j))
#define XB_XSUB(j)  (1280 + 64 * (j))
#define XB_XGEN(j)  (2304 + 64 * (j))
#define XB_TOP      3328
#define XB_TOPGEN   3392
#define XCD_BAR_WORDS 3456
#define XB_SPIN_CAP (1u << 18)


__device__ __forceinline__ unsigned xb_ld(unsigned* p)              { return __hip_atomic_load(p, __ATOMIC_RELAXED, __HIP_MEMORY_SCOPE_AGENT); }
__device__ __forceinline__ unsigned xb_add(unsigned* p, unsigned v) { return __hip_atomic_fetch_add(p, v, __ATOMIC_RELAXED, __HIP_MEMORY_SCOPE_AGENT); }
__device__ __forceinline__ unsigned xb_xcc_id() { return (unsigned)__builtin_amdgcn_s_getreg((3 << 11) | 20) & 0xFu; }
#define XB_SPIN(cond, bar) do { unsigned _sp = 0; while (cond) { __builtin_amdgcn_s_sleep(1); \
    if ((++_sp & 255u) == 0u) { if (xb_ld(&(bar)[XB_TMO])) break; if (_sp > XB_SPIN_CAP) { atomicAdd(&(bar)[XB_TMO], 1u); break; } } } } while (0)

struct XcdBarrier {
    unsigned* bar; unsigned x;
    volatile LAS unsigned* st;
};

__device__ __forceinline__ XcdBarrier xcd_barrier_post(unsigned* bar, volatile LAS unsigned* st) {
    XcdBarrier b; b.bar = bar; b.x = xb_xcc_id(); b.st = st;
    if (threadIdx.x == 0) (void)xb_add(&bar[XB_XCNT(b.x)], 1u);
    return b;
}
__device__ __forceinline__ void xcd_barrier_complete(unsigned* bar, unsigned x, unsigned& nloc, unsigned& nx) {
    const unsigned G = gridDim.x * gridDim.y * gridDim.z;
    unsigned sum, cnt, mine, sp = 0u;
    for (;;) {
        sum = 0u; cnt = 0u; mine = 0u;
#pragma unroll
        for (unsigned j = 0; j < 16; ++j) { const unsigned c = xb_ld(&bar[XB_XCNT(j)]); sum += c; cnt += (c > 0u) ? 1u : 0u; mine = (j == x) ? c : mine; }
        if (sum == G) break;
        __builtin_amdgcn_s_sleep(1);
        if ((++sp & 255u) == 0u) { if (xb_ld(&bar[XB_TMO])) break; if (sp > XB_SPIN_CAP) { atomicAdd(&bar[XB_TMO], 1u); break; } }
    }
    nloc = mine > 0u ? mine : 1u; nx = cnt > 0u ? cnt : 1u;
}

__device__ __forceinline__ void xcd_barrier(const XcdBarrier& b) {
    asm volatile("s_waitcnt vmcnt(0)" ::: "memory");
    __syncthreads();
    if (threadIdx.x == 0) {
        unsigned* bar = b.bar;
        __builtin_amdgcn_s_waitcnt(0);
        unsigned nloc = b.st[0], nx = b.st[1];
        if (nloc == 0u) { xcd_barrier_complete(bar, b.x, nloc, nx); b.st[0] = nloc; b.st[1] = nx; }
        const unsigned old = xb_add(&bar[XB_XSUB(b.x)], 1u);
        const unsigned gen = old / nloc;
        if (old + 1u == (gen + 1u) * nloc) {
            __builtin_amdgcn_fence(__ATOMIC_RELEASE, "agent");
            asm volatile("s_waitcnt vmcnt(0)" ::: "memory");
            const unsigned og = xb_add(&bar[XB_TOP], 1u);
            const unsigned tg = og / nx;
            if (og + 1u == (tg + 1u) * nx) xb_add(&bar[XB_TOPGEN], 1u);
            else XB_SPIN(xb_ld(&bar[XB_TOPGEN]) == tg, bar);
            __builtin_amdgcn_fence(__ATOMIC_ACQUIRE, "agent");
            xb_add(&bar[XB_XGEN(b.x)], 1u);
            asm volatile("s_waitcnt vmcnt(0)" ::: "memory");
        } else {
            XB_SPIN(xb_ld(&bar[XB_XGEN(b.x)]) == gen, bar);
            __builtin_amdgcn_fence(__ATOMIC_ACQUIRE, "agent");
            asm volatile("s_waitcnt vmcnt(0)" ::: "memory");
        }
    }
    __syncthreads();
}

using pg8::bf16_t; using pg8::bf16x8; using pg8::f32x4; using pg8::u32x4; using pg8::Unit; using pg8::BM; using pg8::HALF;
typedef float f32x2 __attribute__((ext_vector_type(2)));
typedef unsigned u32x2 __attribute__((ext_vector_type(2)));
typedef _Float16 f16x4 __attribute__((ext_vector_type(4)));

constexpr int D = 1024, FF = 2816, NIN = 1536, GWID = 512, DEPTH = 4;
constexpr int SEQ = 2048, NB = 8, MP = NB * SEQ, MS = 128, MV = MP + MS, MPAD = 16640;
constexpr int NTHR = 512, NWAVES = 8;
constexpr int LDS_STAGE = 131072, LDS_BYTES = LDS_STAGE + 16;
constexpr float LN_EPS = 1e-5f;
constexpr float ALPHA = 1.6817928305074292f;

constexpr size_t W_GU1 = 0, W_D1 = W_GU1 + (size_t)2 * FF * D, W_IN = W_D1 + (size_t)FF * D, W_OUT = W_IN + (size_t)NIN * D,
                 W_GU2 = W_OUT + (size_t)D * D, W_D2 = W_GU2 + (size_t)2 * FF * D, W_LAYER = W_D2 + (size_t)FF * D;
constexpr size_t WS_W = 0;
constexpr size_t WS_SMALL = WS_W + W_LAYER * 2 * DEPTH;
constexpr size_t SMALL_LAYER = 32768 * 2 + 65536;
constexpr size_t WS_X = WS_SMALL + SMALL_LAYER * 2 * DEPTH;
constexpr size_t WS_XN = WS_X + (size_t)MPAD * D * 4;
constexpr size_t WS_HP = WS_XN + (size_t)MPAD * D * 2;
constexpr size_t WS_MIX = WS_HP + (size_t)MPAD * NIN * 4;
constexpr size_t WS_AGG = WS_MIX + (size_t)MPAD * D * 2;
constexpr size_t WS_BAR = WS_AGG + (size_t)NB * 32 * 2 * 512 * 4;
constexpr size_t WS_END = WS_BAR + 16384;
static_assert((size_t)MPAD * FF * 2 <= (size_t)MPAD * NIN * 4, "hid fits in the proj region");
static_assert(WS_END <= 408000000ull, "workspace budget");

constexpr size_t O_Y = 0, O_PH = (size_t)MV * D, O_PC = O_PH + (size_t)DEPTH * NB * GWID, O_PP = O_PC + (size_t)DEPTH * NB * 3 * GWID,
                 O_SH = O_PP + (size_t)DEPTH * NB * 15 * GWID, O_SC = O_SH + (size_t)DEPTH * MS * GWID, O_SP = O_SC + (size_t)DEPTH * MS * 3 * GWID;

struct Params { const float* in[24]; float* out; unsigned char* ws; };
typedef const Params __attribute__((address_space(4))) CParams;
enum { I_XP = 0, I_XS, I_SH, I_SC, I_SP, I_LNG, I_LNB, I_W1G, I_W1U, I_W1D, I_WIN, I_CW, I_CB, I_GAW, I_GAB, I_GXW, I_GXB, I_LAM, I_PW, I_PS, I_WOUT, I_W2G, I_W2U, I_W2D };

__device__ __forceinline__ unsigned pk2(float lo, float hi) { return pg8::cvt_pk_bf16(lo, hi); }
__device__ __forceinline__ bf16_t f2bf(float f) { return (bf16_t)(pg8::cvt_pk_bf16(f, 0.f) & 0xffffu); }
__device__ __forceinline__ float wave_sum(float v) {
#pragma unroll
    for (int o = 1; o < 64; o <<= 1) v += __shfl_xor(v, o);
    return v;
}
__device__ __forceinline__ float sigmoidf_(float x) { return 1.0f / (1.0f + __expf(-x)); }
__device__ __forceinline__ float gelu_tanh(float x) {
    const float z = 0.7978845608028654f * (x + 0.044715f * x * x * x);
    const float e = __expf(2.0f * z);
    const float th = 1.0f - 2.0f / (e + 1.0f);
    return 0.5f * x * (1.0f + th);
}

struct EpiSwiglu {
    static constexpr bool PERM = true, AFTER_DRAIN = false;
    bf16_t* O; int ldc;
    __device__ __forceinline__ void operator()(const f32x4 (&acc)[2][2][4][2], const Unit& u, int wr, int wc, int fr, int fq) const {
        const int row0 = u.pm * BM + wr * 64 + fr, col0 = u.pn * 128 + wc * 32 + 8 * fq;
#pragma unroll
        for (int ai = 0; ai < 2; ++ai)
#pragma unroll
            for (int m = 0; m < 4; ++m) {
                bf16_t* rowp = O + (size_t)(row0 + ai * HALF + m * 16) * ldc + col0;
                float h[8];
#pragma unroll
                for (int n = 0; n < 2; ++n)
#pragma unroll
                    for (int j = 0; j < 4; ++j) { const float g = acc[ai][0][m][n][j], up = acc[ai][1][m][n][j]; h[n * 4 + j] = g * __builtin_amdgcn_rcpf(1.0f + __expf(-g)) * up; }
                u32x4 w; w.x = pk2(h[0], h[1]); w.y = pk2(h[2], h[3]); w.z = pk2(h[4], h[5]); w.w = pk2(h[6], h[7]);
                *(u32x4*)rowp = w;
            }
    }
};
struct EpiResid {
    static constexpr bool PERM = false, AFTER_DRAIN = false;
    float* X; int ldc; float alpha, coef;
    __device__ __forceinline__ void operator()(const f32x4 (&acc)[2][2][4][2], const Unit& u, int wr, int wc, int fr, int fq) const {
        const int row0 = u.pm * BM + wr * 64 + fr, col0 = u.pn * BM + wc * 32 + 4 * fq;
#pragma unroll
        for (int ai = 0; ai < 2; ++ai)
#pragma unroll
            for (int m = 0; m < 4; ++m) { float* rowp = X + (size_t)(row0 + ai * HALF + m * 16) * ldc + col0;
#pragma unroll
                for (int bj = 0; bj < 2; ++bj)
#pragma unroll
                    for (int n = 0; n < 2; ++n) { f32x4* p = (f32x4*)(rowp + bj * HALF + n * 16); const f32x4 v = *p; *p = v * alpha + acc[ai][bj][m][n] * coef; } }
    }
};

__device__ __forceinline__ void transpose_item(const float* W, int K, int N, bf16_t* WT, int mode, LAS float* scr, int item, int lane) {
    const int nblk = N / 32, kb = item / nblk, nb = item % nblk, k0 = 64 * kb, n0 = 32 * nb;
    const int drow0 = mode == 0 ? n0 : (256 * (n0 >> 7) + (n0 & 127) + (mode == 2 ? 128 : 0));
#pragma unroll 8
    for (int i = 0; i < 32; ++i) { const int kk = 2 * i + (lane >> 5); scr[kk * 33 + (lane & 31)] = W[(size_t)(k0 + kk) * N + n0 + (lane & 31)]; }
    asm volatile("s_waitcnt lgkmcnt(0)" ::: "memory");
    const int c = lane & 7;
#pragma unroll
    for (int j = 0; j < 4; ++j) { const int n = (lane >> 3) + 8 * j; const LAS float* s = scr + (8 * c) * 33 + n;
        u32x4 o; o.x = pk2(s[0 * 33], s[1 * 33]); o.y = pk2(s[2 * 33], s[3 * 33]); o.z = pk2(s[4 * 33], s[5 * 33]); o.w = pk2(s[6 * 33], s[7 * 33]);
        *(u32x4*)(WT + (size_t)(drow0 + n) * K + k0 + 8 * c) = o; }
    asm volatile("s_waitcnt lgkmcnt(0)" ::: "memory");
}
__device__ __forceinline__ void prologue(CParams* P, LAS unsigned char* lds, int gw, int NGW, int wave, int lane) {
    LAS float* scr = (LAS float*)(lds + wave * 16384);
    bf16_t* Wb = (bf16_t*)(P->ws + WS_W);
    constexpr int I_G = (D / 64) * (FF / 32), I_DN = (FF / 64) * (D / 32), I_I = (D / 64) * (NIN / 32), I_O = (D / 64) * (D / 32);
    constexpr int PER_LAYER = 4 * I_G + 2 * I_DN + I_I + I_O;
    for (int it = gw; it < PER_LAYER * DEPTH; it += NGW) {
        const int l = it / PER_LAYER; int r = it % PER_LAYER; bf16_t* WL = Wb + (size_t)l * W_LAYER;
        if (r < I_G) { transpose_item(P->in[I_W1G] + (size_t)l * D * FF, D, FF, WL + W_GU1, 1, scr, r, lane); continue; } r -= I_G;
        if (r < I_G) { transpose_item(P->in[I_W1U] + (size_t)l * D * FF, D, FF, WL + W_GU1, 2, scr, r, lane); continue; } r -= I_G;
        if (r < I_DN) { transpose_item(P->in[I_W1D] + (size_t)l * D * FF, FF, D, WL + W_D1, 0, scr, r, lane); continue; } r -= I_DN;
        if (r < I_I) { transpose_item(P->in[I_WIN] + (size_t)l * D * NIN, D, NIN, WL + W_IN, 0, scr, r, lane); continue; } r -= I_I;
        if (r < I_O) { transpose_item(P->in[I_WOUT] + (size_t)l * D * D, D, D, WL + W_OUT, 0, scr, r, lane); continue; } r -= I_O;
        if (r < I_G) { transpose_item(P->in[I_W2G] + (size_t)l * D * FF, D, FF, WL + W_GU2, 1, scr, r, lane); continue; } r -= I_G;
        if (r < I_G) { transpose_item(P->in[I_W2U] + (size_t)l * D * FF, D, FF, WL + W_GU2, 2, scr, r, lane); continue; } r -= I_G;
        transpose_item(P->in[I_W2D] + (size_t)l * D * FF, FF, D, WL + W_D2, 0, scr, r, lane);
    }
    bf16_t* Sm = (bf16_t*)(P->ws + WS_SMALL);
    const int gt = gw * 64 + lane, NGT = NGW * 64;
    for (int o = gt; o < DEPTH * 32768; o += NGT) {
        const int l = o / 32768, rem = o % 32768, h = rem / 4096, j = (rem / 64) % 64, i = rem % 64;
        const size_t src = (size_t)l * 32768 + h * 4096 + i * 64 + j;
        Sm[(size_t)l * SMALL_LAYER + rem] = f2bf(P->in[I_GAW][src]);
        Sm[(size_t)l * SMALL_LAYER + 32768 + rem] = f2bf(P->in[I_GXW][src]);
    }
    for (int o = gt; o < DEPTH * 65536; o += NGT) {
        const int l = o / 65536, rem = o % 65536, g = rem / 16384, j = (rem / 128) % 128, i = rem % 128;
        Sm[(size_t)l * SMALL_LAYER + 65536 + rem] = f2bf(P->in[I_PW][(size_t)l * 65536 + g * 16384 + i * 128 + j]);
    }
    float* X = (float*)(P->ws + WS_X); bf16_t* XN = (bf16_t*)(P->ws + WS_XN);
    for (int m = gw; m < MV; m += NGW) {
        const float* src = m < MP ? P->in[I_XP] + (size_t)m * D : P->in[I_XS] + (size_t)(m - MP) * D;
        const f32x4* xr = (const f32x4*)src + lane; f32x4* xo = (f32x4*)(X + (size_t)m * D) + lane; u32x2* o8 = (u32x2*)(XN + (size_t)m * D) + lane;
#pragma unroll
        for (int j = 0; j < 4; ++j) { const f32x4 v = xr[64 * j]; xo[64 * j] = v; u32x2 w; w.x = pk2(v[0], v[1]); w.y = pk2(v[2], v[3]); o8[64 * j] = w; }
    }
}

__device__ __forceinline__ void ln_pass(float* X, bf16_t* XN, float* OUT, const float* g, const float* b, int gw, int NGW, int lane) {
    f32x4 gg[4], bb[4];
#pragma unroll
    for (int j = 0; j < 4; ++j) { gg[j] = ((const f32x4*)g)[lane + 64 * j]; bb[j] = ((const f32x4*)b)[lane + 64 * j]; }
    for (int m = gw; m < MV; m += NGW) {
        const f32x4* xr = (const f32x4*)(X + (size_t)m * D) + lane;
        f32x4 v[4]; float s = 0.f;
#pragma unroll
        for (int j = 0; j < 4; ++j) { v[j] = xr[64 * j]; s += (v[j][0] + v[j][1]) + (v[j][2] + v[j][3]); }
        const float mean = wave_sum(s) * (1.f / D); float s2 = 0.f;
#pragma unroll
        for (int j = 0; j < 4; ++j) { v[j] = v[j] - mean; s2 += (v[j][0] * v[j][0] + v[j][1] * v[j][1]) + (v[j][2] * v[j][2] + v[j][3] * v[j][3]); }
        const float rstd = 1.0f / sqrtf(wave_sum(s2) * (1.f / D) + LN_EPS);
        f32x4* xo = (f32x4*)((OUT ? OUT : X) + (size_t)m * D) + lane; u32x2* o8 = (u32x2*)(XN + (size_t)m * D) + lane;
#pragma unroll
        for (int j = 0; j < 4; ++j) { const f32x4 y = v[j] * rstd * gg[j] + bb[j]; xo[64 * j] = y; u32x2 w; w.x = pk2(y[0], y[1]); w.y = pk2(y[2], y[3]); o8[64 * j] = w; }
    }
}

constexpr int XCS = 520;
constexpr int XC_OFF = 0, R_OFF = 32 * XCS * 2, I_OFF = 2 * 32 * XCS * 2;

__device__ __forceinline__ void gates_mfma(LAS unsigned char* lds, const bf16_t* WaT, const bf16_t* WxT, const float* ba, const float* bx, int h, int fr, int fq) {
    bf16x8 A[2][2];
#pragma unroll
    for (int mb = 0; mb < 2; ++mb)
#pragma unroll
        for (int kb = 0; kb < 2; ++kb) A[mb][kb] = *(const LAS bf16x8*)(lds + XC_OFF + ((mb * 16 + fr) * XCS + 64 * h + kb * 32 + 8 * fq) * 2);
#pragma unroll
    for (int gate = 0; gate < 2; ++gate) {
        const bf16_t* W = (gate ? WxT : WaT) + h * 4096; const float* bias = (gate ? bx : ba) + 64 * h; const int ooff = gate ? I_OFF : R_OFF;
#pragma unroll
        for (int nb = 0; nb < 4; ++nb) {
            const bf16x8 B0 = *(const bf16x8*)(W + (nb * 16 + fr) * 64 + 8 * fq), B1 = *(const bf16x8*)(W + (nb * 16 + fr) * 64 + 32 + 8 * fq);
            const f32x4 bv = *(const f32x4*)(bias + nb * 16 + 4 * fq);
#pragma unroll
            for (int mb = 0; mb < 2; ++mb) {
                f32x4 acc = (f32x4){0.f, 0.f, 0.f, 0.f};
                acc = __builtin_amdgcn_mfma_f32_16x16x32_bf16(B0, A[mb][0], acc, 0, 0, 0);
                acc = __builtin_amdgcn_mfma_f32_16x16x32_bf16(B1, A[mb][1], acc, 0, 0, 0);
                acc = acc + bv;
                f16x4 hv; hv[0] = (_Float16)sigmoidf_(acc[0]); hv[1] = (_Float16)sigmoidf_(acc[1]); hv[2] = (_Float16)sigmoidf_(acc[2]); hv[3] = (_Float16)sigmoidf_(acc[3]);
                *(LAS f16x4*)(lds + ooff + ((mb * 16 + fr) * XCS + 64 * h + nb * 16 + 4 * fq) * 2) = hv;
            }
        }
    }
}
__device__ __forceinline__ void pool_mfma(LAS unsigned char* lds, const bf16_t* PWT, const float* pscale, bf16_t* mixrow, int w, int fr, int fq) {
    const int g = w >> 1, half = w & 1;
    f32x4 acc[4][4];
#pragma unroll
    for (int mb = 0; mb < 4; ++mb)
#pragma unroll
        for (int nb = 0; nb < 4; ++nb) acc[mb][nb] = (f32x4){0.f, 0.f, 0.f, 0.f};
#pragma unroll
    for (int kb = 0; kb < 4; ++kb) {
        bf16x8 A[4];
#pragma unroll
        for (int mb = 0; mb < 4; ++mb) A[mb] = *(const LAS bf16x8*)(lds + ((mb * 16 + fr) * XCS + 128 * g + kb * 32 + 8 * fq) * 2);
#pragma unroll
        for (int nb = 0; nb < 4; ++nb) {
            const bf16x8 B = *(const bf16x8*)(PWT + ((size_t)g * 128 + 64 * half + nb * 16 + fr) * 128 + kb * 32 + 8 * fq);
#pragma unroll
            for (int mb = 0; mb < 4; ++mb) acc[mb][nb] = __builtin_amdgcn_mfma_f32_16x16x32_bf16(B, A[mb], acc[mb][nb], 0, 0, 0);
        }
    }
#pragma unroll
    for (int nb = 0; nb < 4; ++nb) {
        const int ch = 128 * g + 64 * half + nb * 16 + 4 * fq; const f32x4 sc = *(const f32x4*)(pscale + ch);
#pragma unroll
        for (int mb = 0; mb < 4; ++mb) { const f32x4 v = acc[mb][nb] * sc; u32x2 o; o.x = pk2(v[0], v[1]); o.y = pk2(v[2], v[3]);
            *(u32x2*)(mixrow + (size_t)(mb * 16 + fr) * D + GWID + ch) = o; }
    }
}
__device__ __forceinline__ void pool_prompt_thread(const float* UP, int t0, int W, LAS bf16_t* PL, int c) {
    float s = 0.f;
    if (t0 > 0) for (int k = 1; k < W; ++k) s += UP[-k * NIN];
#pragma unroll 8
    for (int t = 0; t < 64; ++t) {
        const float v = UP[t * NIN]; s += v;
        const float cnt = fminf((float)W, (float)(t0 + t + 1)); PL[t * XCS + c] = f2bf(s / cnt - v);
        const float old = (t0 + t - W + 1 >= 0) ? UP[(t - W + 1) * NIN] : 0.f; s -= old;
    }
}
__device__ __forceinline__ void pool_sample_thread(const float* UP  , const float* SPs  , float* SPo, int W, LAS bf16_t* PL, int c) {
#pragma unroll 2
    for (int t = 0; t < 64; ++t) {
        const float v = UP[(size_t)t * NIN]; float s = v;
        const float* sp = SPs + (size_t)t * 15 * GWID; float* so = SPo + (size_t)t * 15 * GWID;
#pragma unroll
        for (int k = 0; k < 15; ++k) { const float q = sp[k * GWID]; if (k >= 16 - W) s += q; if (k >= 1) so[(k - 1) * GWID] = q; }
        so[14 * GWID] = v;
        PL[t * XCS + c] = f2bf(s / (float)W - v);
    }
}

struct MixW {
    const float *cw, *cb, *gab, *gxb, *lam, *psc; const bf16_t *GAT, *GXT, *PWT;
};

__global__ void __launch_bounds__(NTHR, 2) fwd_megakernel(Params p) {
    extern __shared__ __attribute__((aligned(16))) unsigned char lds_raw[];
    LAS unsigned char* lds = (LAS unsigned char*)lds_raw;
    cg::grid_group grid = cg::this_grid();
    const int G = gridDim.x, bid = blockIdx.x, NGW = G * NWAVES;

    if (threadIdx.x == 0) { ((LAS unsigned*)(lds + LDS_STAGE))[0] = 0u; ((LAS unsigned*)(lds + LDS_STAGE))[1] = 0u; }
    __syncthreads();
    (void)xcd_barrier_post((unsigned*)(((CParams*)__builtin_amdgcn_kernarg_segment_ptr())->ws + WS_BAR), (volatile LAS unsigned*)(lds + LDS_STAGE));
#define GSYNC() do { XcdBarrier b_; b_.bar = (unsigned*)(ws + WS_BAR); b_.x = xb_xcc_id(); b_.st = (volatile LAS unsigned*)(lds + LDS_STAGE); xcd_barrier(b_); } while (0)
    { const int tid = threadIdx.x, lane = tid & 63, wave = __builtin_amdgcn_readfirstlane(tid >> 6);
      prologue((CParams*)__builtin_amdgcn_kernarg_segment_ptr(), lds, bid * NWAVES + wave, NGW, wave, lane); }
    grid.sync();

    constexpr int NK = 10;
    for (int ph = 0; ph < DEPTH * NK; ++ph) {
        const int l = ph / NK, kind = ph % NK;
        int tid = threadIdx.x; asm volatile("" : "+v"(tid));
        const int lane = tid & 63, wave = __builtin_amdgcn_readfirstlane(tid >> 6), fr = lane & 15, fq = lane >> 4, gw = bid * NWAVES + wave;
        CParams* P = (CParams*)__builtin_amdgcn_kernarg_segment_ptr(); asm volatile("" : "+s"(P));
        unsigned char* const ws = P->ws;
        float* X = (float*)(ws + WS_X); bf16_t* XN = (bf16_t*)(ws + WS_XN); bf16_t* HID = (bf16_t*)(ws + WS_HP); float* PROJ = (float*)(ws + WS_HP);
        bf16_t* MIX = (bf16_t*)(ws + WS_MIX); float* AGG = (float*)(ws + WS_AGG);
        const bf16_t* Wb = (const bf16_t*)(ws + WS_W); const bf16_t* Sm = (const bf16_t*)(ws + WS_SMALL);
        const bf16_t* WL = Wb + (size_t)l * W_LAYER;
        if (kind == 0 || kind == 7) {
            pg8::Gemm g{XN, WL + (kind == 0 ? W_GU1 : W_GU2), MPAD, 2 * FF, D}; pg8::StaticOrder S; S.init(MPAD, 2 * FF, G, bid);
            EpiSwiglu E{HID, FF};
            pg8::gemm_phase<EpiSwiglu, pg8::StaticOrder>(lds, g, S, E, nullptr);
        } else if (kind == 1 || kind == 8 || kind == 5) {
            const bool wo = (kind == 5);
            pg8::Gemm g{wo ? MIX : HID, WL + (wo ? W_OUT : (kind == 1 ? W_D1 : W_D2)), MPAD, D, wo ? D : FF}; pg8::StaticOrder S; S.init(MPAD, D, G, bid);
            EpiResid E{X, D, ALPHA, wo ? 1.0f : 0.5f};
            pg8::gemm_phase<EpiResid, pg8::StaticOrder>(lds, g, S, E, nullptr);
        } else if (kind == 3) {
            pg8::Gemm g{XN, WL + W_IN, MPAD, NIN, D}; pg8::StaticOrder S; S.init(MPAD, NIN, G, bid);
            pg8::EpiF32 E{PROJ, NIN, nullptr};
            pg8::gemm_phase<pg8::EpiF32, pg8::StaticOrder>(lds, g, S, E, nullptr);
        } else if (kind == 2 || kind == 6 || kind == 9) {
            const int which = kind == 2 ? 0 : (kind == 6 ? 1 : 2);
            const bool fin = (l == DEPTH - 1 && which == 2);
            ln_pass(X, XN, fin ? P->out + O_Y : nullptr, P->in[I_LNG] + (size_t)(l * 3 + which) * D, P->in[I_LNB] + (size_t)(l * 3 + which) * D, gw, NGW, lane);
        } else {
            MixW mw; mw.cw = P->in[I_CW] + (size_t)l * 4 * GWID; mw.cb = P->in[I_CB] + (size_t)l * GWID; mw.gab = P->in[I_GAB] + (size_t)l * GWID; mw.gxb = P->in[I_GXB] + (size_t)l * GWID;
            mw.lam = P->in[I_LAM] + (size_t)l * GWID; mw.psc = P->in[I_PS] + (size_t)l * GWID;
            mw.GAT = Sm + (size_t)l * SMALL_LAYER; mw.GXT = mw.GAT + 32768; mw.PWT = mw.GAT + 65536;
            const int c = tid;
            const bool has = bid < NB * 32;
            const int b = bid >> 5, j = bid & 31, t0 = j * 64; const size_t row0 = (size_t)b * SEQ + t0;
            const float cw0 = mw.cw[c], cw1 = mw.cw[GWID + c], cw2 = mw.cw[2 * GWID + c], cw3 = mw.cw[3 * GWID + c], cbv = mw.cb[c];
            const float lamv = mw.lam[c]; const float k8 = -8.0f * log1pf(__expf(-lamv));
            if (has) {
                {
                    const float* UP = PROJ + row0 * NIN + 2 * GWID + c; LAS bf16_t* PL = (LAS bf16_t*)lds;
                    pool_prompt_thread(UP, t0, 2 << (wave >> 1), PL, c);
                    if (j == 31) { float* o = P->out + O_PP + ((size_t)(l * NB + b) * 15) * GWID + c;
#pragma unroll
                        for (int k = 0; k < 15; ++k) o[k * GWID] = UP[(49 + k) * NIN]; }
                    __syncthreads();
                    pool_mfma(lds, mw.PWT, mw.psc, MIX + row0 * D, wave, fr, fq);
                    __syncthreads();
                }
            }
            for (int pass = 0; pass < 2; ++pass) {
                if (has) {
                    float h = 0.f, cum = 1.f;
                    if (pass == 1) for (int i = 0; i < j; ++i) { const float A_ = AGG[((size_t)(b * 32 + i) * 2 + 0) * GWID + c], H_ = AGG[((size_t)(b * 32 + i) * 2 + 1) * GWID + c]; h = A_ * h + H_; }
                    const float* U = PROJ + row0 * NIN + c; bf16_t* mo = MIX + row0 * D + c;
                    float p0 = 0.f, p1 = 0.f, p2 = 0.f;
                    if (j > 0) { p0 = U[-3 * NIN]; p1 = U[-2 * NIN]; p2 = U[-1 * NIN]; }
                    for (int s = 0; s < 2; ++s) {
                        float xc[32];
#pragma unroll
                        for (int t = 0; t < 32; ++t) { const float v = U[(s * 32 + t) * NIN]; xc[t] = cbv + cw0 * p0 + cw1 * p1 + cw2 * p2 + cw3 * v; p0 = p1; p1 = p2; p2 = v;
                            ((LAS bf16_t*)(lds + XC_OFF))[t * XCS + c] = f2bf(xc[t]); if ((t & 7) == 7) asm volatile("" ::: "memory"); }
                        __syncthreads();
                        gates_mfma(lds, mw.GAT, mw.GXT, mw.gab, mw.gxb, wave, fr, fq);
                        __syncthreads();
#pragma unroll
                        for (int t = 0; t < 32; ++t) {
                            const float r = (float)((const LAS _Float16*)(lds + R_OFF))[t * XCS + c], ig = (float)((const LAS _Float16*)(lds + I_OFF))[t * XCS + c];
                            const float la = r * k8, a = __expf(la), mult = sqrtf(-expm1f(2.0f * la)), uu = mult * (ig * xc[t]);
                            h = a * h + uu; cum *= a;
                            if (pass == 1) mo[(size_t)(s * 32 + t) * D] = f2bf(h * gelu_tanh(U[(s * 32 + t) * NIN + GWID]));
                            if ((t & 7) == 7) asm volatile("" ::: "memory");
                        }
                        __syncthreads();
                    }
                    if (pass == 0) {
                        AGG[((size_t)(b * 32 + j) * 2 + 0) * GWID + c] = cum; AGG[((size_t)(b * 32 + j) * 2 + 1) * GWID + c] = h;
                        if (j == 31) { float* o = P->out + O_PC + ((size_t)(l * NB + b) * 3) * GWID + c; o[0] = p0; o[GWID] = p1; o[2 * GWID] = p2; }
                    } else if (j == 31) P->out[O_PH + (size_t)(l * NB + b) * GWID + c] = h;
                }
                if (pass == 0) GSYNC();
            }
            if (bid >= G - 2) {
                const int b0 = (bid - (G - 2)) * 64; const size_t srow0 = (size_t)MP + b0;
                __syncthreads();
                {
                    const float* UP = PROJ + srow0 * NIN + 2 * GWID + c; LAS bf16_t* PL = (LAS bf16_t*)lds;
                    const float* SPs = P->in[I_SP] + ((size_t)(l * MS + b0) * 15) * GWID + c; float* SPo = P->out + O_SP + ((size_t)(l * MS + b0) * 15) * GWID + c;
                    pool_sample_thread(UP, SPs, SPo, 2 << (wave >> 1), PL, c);
                    __syncthreads();
                    pool_mfma(lds, mw.PWT, mw.psc, MIX + srow0 * D, wave, fr, fq);
                    __syncthreads();
                }
                for (int s = 0; s < 2; ++s) {
                    const size_t r0 = srow0 + s * 32; const int bb0 = b0 + s * 32;
                    float xc[32];
#pragma unroll
                    for (int t = 0; t < 32; ++t) {
                        const float v = PROJ[(r0 + t) * NIN + c]; const float* sc = P->in[I_SC] + ((size_t)(l * MS + bb0 + t) * 3) * GWID + c;
                        const float s0 = sc[0], s1 = sc[GWID], s2 = sc[2 * GWID];
                        xc[t] = cbv + cw0 * s0 + cw1 * s1 + cw2 * s2 + cw3 * v;
                        float* so = P->out + O_SC + ((size_t)(l * MS + bb0 + t) * 3) * GWID + c; so[0] = s1; so[GWID] = s2; so[2 * GWID] = v;
                        ((LAS bf16_t*)(lds + XC_OFF))[t * XCS + c] = f2bf(xc[t]);
                        if ((t & 3) == 3) asm volatile("" ::: "memory");
                    }
                    __syncthreads();
                    gates_mfma(lds, mw.GAT, mw.GXT, mw.gab, mw.gxb, wave, fr, fq);
                    __syncthreads();
#pragma unroll
                    for (int t = 0; t < 32; ++t) {
                        const float r = (float)((const LAS _Float16*)(lds + R_OFF))[t * XCS + c], ig = (float)((const LAS _Float16*)(lds + I_OFF))[t * XCS + c];
                        const float la = r * k8, a = __expf(la), mult = sqrtf(-expm1f(2.0f * la)), uu = mult * (ig * xc[t]);
                        const float h0 = P->in[I_SH][(size_t)(l * MS + bb0 + t) * GWID + c];
                        const float hh = a * h0 + uu;
                        P->out[O_SH + (size_t)(l * MS + bb0 + t) * GWID + c] = hh;
                        MIX[(r0 + t) * D + c] = f2bf(hh * gelu_tanh(PROJ[(r0 + t) * NIN + GWID + c]));
                        if ((t & 3) == 3) asm volatile("" ::: "memory");
                    }
                    __syncthreads();
                }
            }
        }
        if (ph != DEPTH * NK - 1) GSYNC();
    }
}

extern "C" void kernel_launch(void* const* d_in, const int* in_sizes, int n_in, void* d_out, int out_size, void* d_ws, size_t ws_size, hipStream_t stream) {
    static int grid_blocks = 0;
    if (!grid_blocks) {
        int dev = 0, cus = 0, per_cu = 0;
        hipGetDevice(&dev);
        hipDeviceGetAttribute(&cus, hipDeviceAttributeMultiprocessorCount, dev);
        hipFuncSetAttribute((const void*)fwd_megakernel, hipFuncAttributeMaxDynamicSharedMemorySize, LDS_BYTES);
        hipOccupancyMaxActiveBlocksPerMultiprocessor(&per_cu, (const void*)fwd_megakernel, NTHR, LDS_BYTES);
        if (per_cu < 1) per_cu = 1;
        grid_blocks = cus * per_cu;
        if (grid_blocks > 256) grid_blocks = 256;
        if (ws_size < WS_END) fprintf(stderr, "kernel_launch: workspace too small: %zu < %zu\n", ws_size, (size_t)WS_END);
    }
    Params p{};
    for (int i = 0; i < 24; ++i) p.in[i] = (const float*)d_in[i];
    p.out = (float*)d_out; p.ws = (unsigned char*)d_ws;
    (void)hipMemsetAsync((unsigned char*)d_ws + WS_BAR, 0, 16384, stream);
    void* args[] = {&p};
    hipError_t e = hipLaunchCooperativeKernel((const void*)fwd_megakernel, dim3(grid_blocks), dim3(NTHR), args, LDS_BYTES, stream);
    if (e != hipSuccess) fprintf(stderr, "cooperative launch failed: %s (grid %d)\n", hipGetErrorString(e), grid_blocks);
}
```

```cpp
#include <hip/hip_runtime.h>
#include <hip/hip_cooperative_groups.h>
#include <cstdio>
namespace cg = cooperative_groups;
namespace pg8 {
#define PG8_LAS __attribute__((address_space(3)))
typedef unsigned short bf16_t;
typedef short bf16x8 __attribute__((ext_vector_type(8)));
typedef float f32x4 __attribute__((ext_vector_type(4)));
typedef unsigned u32x4 __attribute__((ext_vector_type(4)));
constexpr int BM = 256, BK = 64, HALF = 128, HTB = HALF * BK * 2  , STAGE_BYTES = 8 * HTB, NXCD = 8, WGM = 8;

__host__ __device__ __forceinline__ int lds_byte(int r, int c) { const int st = (r >> 4) * 2 + (c >> 5), rr = r & 15, cc = c & 31, ob = rr * 64 + cc * 2; return st * 1024 + (ob ^ (((ob >> 9) & 1) << 5)); }
__host__ __device__ __forceinline__ void stage_rc(int b, int& R, int& C) { const int st = b / 1024, sb = b % 1024, swz = sb ^ (((sb >> 9) & 1) << 5); R = (st >> 1) * 16 + swz / 64; C = (st & 1) * 32 + (swz % 64) / 2; }
__host__ __device__ __forceinline__ int perm32(int rho) { const int n = rho >> 4, i = rho & 15; return 8 * (i >> 2) + 4 * n + (i & 3); }

struct Unit { int pm, pn; };
struct Gemm { const bf16_t* A; const bf16_t* Bt; int M, N, K; };

struct StaticOrder {
    int nM, nN, nwg, G, c;
    __host__ __device__ void init(int M, int N, int G_, int c_) { nM = M / BM; nN = N / BM; nwg = nM * nN; G = G_; c = c_; }
    __host__ __device__ bool next(int i, Unit& u) const {
        const long L = (long)i * G + c; if (L >= nwg) return false;
        int wgid = (int)L; { const int q = nwg / NXCD, r = nwg % NXCD, xcd = wgid % NXCD, off = wgid / NXCD; wgid = (xcd < r ? xcd * (q + 1) : r * (q + 1) + (xcd - r) * q) + off; }
        const int nig = WGM * nN, gid = wgid / nig, fm = gid * WGM, gsz = (nM - fm) < WGM ? (nM - fm) : WGM;
        u.pm = fm + ((wgid % nig) % gsz); u.pn = (wgid % nig) / gsz; return true;
    }
    __device__ __forceinline__ void a_ready(const Unit&) const {}
    __device__ __forceinline__ void done(const Unit&) const {}
};
__device__ __forceinline__ unsigned cvt_pk_bf16(float lo, float hi) { unsigned r; asm volatile("v_cvt_pk_bf16_f32 %0, %1, %2" : "=v"(r) : "v"(lo), "v"(hi)); return r; }
typedef float f32x2 __attribute__((ext_vector_type(2)));
struct EpiF32 {
    static constexpr bool PERM = false, AFTER_DRAIN = false;
    float* C; int ldc; const float* bias;
    __device__ __forceinline__ void operator()(const f32x4 (&acc)[2][2][4][2], const Unit& u, int wr, int wc, int fr, int fq) const {
        const int row0 = u.pm * BM + wr * 64 + fr, col0 = u.pn * BM + wc * 32 + 4 * fq;
        f32x4 bv[2][2];
#pragma unroll
        for (int bj = 0; bj < 2; ++bj)
#pragma unroll
            for (int n = 0; n < 2; ++n) bv[bj][n] = bias ? *(const f32x4*)(bias + col0 + bj * HALF + n * 16) : (f32x4){0.f, 0.f, 0.f, 0.f};
#pragma unroll
        for (int ai = 0; ai < 2; ++ai)
#pragma unroll
            for (int m = 0; m < 4; ++m) { float* rowp = C + (size_t)(row0 + ai * HALF + m * 16) * ldc + col0;
#pragma unroll
                for (int bj = 0; bj < 2; ++bj)
#pragma unroll
                    for (int n = 0; n < 2; ++n) *(f32x4*)(rowp + bj * HALF + n * 16) = acc[ai][bj][m][n] + bv[bj][n]; }
    }
};
template <class Epi, class Sched, bool STAMP = false>
__device__ __forceinline__ void gemm_phase(PG8_LAS unsigned char* lds, const Gemm g, const Sched& S, const Epi& E, unsigned long long* stamps) {
    int tid_l = threadIdx.x; asm volatile("" : "+v"(tid_l));
    const int tid = tid_l, wid = __builtin_amdgcn_readfirstlane(tid >> 6), lane = tid & 63, wr = wid >> 2, wc = wid & 3, fr = lane & 15, fq = lane >> 4;
    const int K = g.K, nt = K / BK;
    int ts_lo = 0, ts_hi = 0, nts = 0; const unsigned long long rt_entry = STAMP ? (unsigned long long)wall_clock64() : 0ull;
#define PG8_STAMP() do { if (STAMP && wid == 0 && nts < 64) { const unsigned long long _c = (unsigned long long)clock64(); \
        ts_lo = (lane == nts) ? (int)(unsigned)_c : ts_lo; ts_hi = (lane == nts) ? (int)(unsigned)(_c >> 32) : ts_hi; ++nts; } } while (0)
    PG8_STAMP();
    unsigned voffA[2], voffB[2];
#pragma unroll
    for (int i = 0; i < 2; ++i) { int R, C; stage_rc(tid * 16 + i * 8192, R, C); const int Rb = Epi::PERM ? ((R & ~31) + perm32(R & 31)) : R;
        voffA[i] = (unsigned)(R * K + C) * 2u; voffB[i] = (unsigned)(Rb * K + C) * 2u; }
    const size_t kstep = (size_t)(BK * 2);
    const size_t hstep = (size_t)HALF * K * 2;
    const size_t tstep = 2 * hstep;
    const unsigned ldsw = (unsigned)wid * 1024u;
    const int aoff = lds_byte(wr * 64 + fr, fq * 8), boff = lds_byte(wc * 32 + fr, fq * 8);
#define PG8_SA(b, h) (((b) * 2 + (h)) * HTB)
#define PG8_SB(b, h) ((4 + (b) * 2 + (h)) * HTB)
#define PG8_STAGE(bufoff, gbase, voff) do { _Pragma("unroll") for (int _i = 0; _i < 2; ++_i) \
        __builtin_amdgcn_global_load_lds((const unsigned*)((const char*)(gbase) + (voff)[_i]), (PG8_LAS unsigned*)(lds + (bufoff) + ldsw + _i * 8192), 16, 0, 0); } while (0)
#define PG8_LDA(dst, b, h) do { _Pragma("unroll") for (int m = 0; m < 4; ++m) _Pragma("unroll") for (int k = 0; k < 2; ++k) dst[m][k] = *(const PG8_LAS bf16x8*)(lds + PG8_SA(b, h) + aoff + m * 2048 + k * 1024); } while (0)
#define PG8_LDB(dst, b, h) do { _Pragma("unroll") for (int n = 0; n < 2; ++n) _Pragma("unroll") for (int k = 0; k < 2; ++k) dst[n][k] = *(const PG8_LAS bf16x8*)(lds + PG8_SB(b, h) + boff + n * 2048 + k * 1024); } while (0)
#define PG8_MMA(ai, bj, At, Bt) do { __builtin_amdgcn_s_setprio(1); _Pragma("unroll") for (int m = 0; m < 4; ++m) _Pragma("unroll") for (int n = 0; n < 2; ++n) _Pragma("unroll") for (int k = 0; k < 2; ++k) \
        acc[ai][bj][m][n] = __builtin_amdgcn_mfma_f32_16x16x32_bf16(Bt[n][k], At[m][k], acc[ai][bj][m][n], 0, 0, 0); __builtin_amdgcn_s_setprio(0); } while (0)
#define PG8_WAIT_V(n) asm volatile("s_waitcnt vmcnt(" #n ")" ::: "memory")
#define PG8_WAIT_L(n) asm volatile("s_waitcnt lgkmcnt(" #n ")" ::: "memory")
#define PG8_BAR __builtin_amdgcn_s_barrier()
#define PG8_SCHED __builtin_amdgcn_sched_barrier(0)
    Unit cur, nxt; int ui = 0;
    if (!S.next(0, cur)) return;
    f32x4 acc[2][2][4][2];
#pragma unroll
    for (int a = 0; a < 2; ++a)
#pragma unroll
        for (int b = 0; b < 2; ++b)
#pragma unroll
            for (int m = 0; m < 4; ++m)
#pragma unroll
                for (int n = 0; n < 2; ++n) acc[a][b][m][n] = (f32x4){0.f, 0.f, 0.f, 0.f};
    bf16x8 At[4][2], B0[2][2], B1[2][2];
    const char* cA = (const char*)g.A + (size_t)cur.pm * tstep; const char* cB = (const char*)g.Bt + (size_t)cur.pn * tstep;
    S.a_ready(cur);
    PG8_STAGE(PG8_SB(0, 0), cB, voffB); PG8_STAGE(PG8_SA(0, 0), cA, voffA); PG8_STAGE(PG8_SB(0, 1), cB + hstep, voffB); PG8_STAGE(PG8_SA(0, 1), cA + hstep, voffA);
    if (wr == 1) PG8_BAR;
    PG8_WAIT_V(4); PG8_BAR;
    PG8_STAGE(PG8_SB(1, 0), cB + kstep, voffB); PG8_STAGE(PG8_SA(1, 0), cA + kstep, voffA); PG8_STAGE(PG8_SB(1, 1), cB + hstep + kstep, voffB);
    PG8_WAIT_V(6); PG8_BAR;
    PG8_STAMP();
    for (;;) {
        const bool has_next = S.next(ui + 1, nxt);
        const char* nA = has_next ? (const char*)g.A + (size_t)nxt.pm * tstep : cA; const char* nB = has_next ? (const char*)g.Bt + (size_t)nxt.pn * tstep : cB;
        for (int t = 0; t < nt; t += 2) {
            const bool last = (t == nt - 2);
            const char* a1 = cA + (size_t)(t + 1) * kstep;
            const char* a2 = last ? nA : cA + (size_t)(t + 2) * kstep; const char* b2 = last ? nB : cB + (size_t)(t + 2) * kstep;
            const char* a3 = a2 + kstep; const char* b3 = b2 + kstep;
            if (last && has_next) S.a_ready(nxt);
            PG8_LDB(B0, 0, 0); PG8_SCHED; PG8_LDA(At, 0, 0); PG8_STAGE(PG8_SA(1, 1), a1 + hstep, voffA);
            PG8_WAIT_L(8); PG8_BAR; PG8_WAIT_L(0); PG8_MMA(0, 0, At, B0); PG8_BAR; PG8_SCHED;
            PG8_LDB(B1, 0, 1); PG8_STAGE(PG8_SB(0, 0), b2, voffB);
            PG8_BAR; PG8_WAIT_L(0); PG8_MMA(0, 1, At, B1); PG8_BAR;
            PG8_LDA(At, 0, 1); PG8_STAGE(PG8_SA(0, 0), a2, voffA);
            PG8_BAR; PG8_WAIT_L(0); PG8_MMA(1, 0, At, B0); PG8_BAR; PG8_SCHED;
            PG8_STAGE(PG8_SB(0, 1), b2 + hstep, voffB);
            PG8_WAIT_V(6); PG8_BAR; PG8_MMA(1, 1, At, B1); PG8_BAR;
            PG8_LDB(B0, 1, 0); PG8_SCHED; PG8_LDA(At, 1, 0); PG8_STAGE(PG8_SA(0, 1), a2 + hstep, voffA);
            PG8_WAIT_L(8); PG8_BAR; PG8_WAIT_L(0); PG8_MMA(0, 0, At, B0); PG8_BAR; PG8_SCHED;
            PG8_LDB(B1, 1, 1); PG8_STAGE(PG8_SB(1, 0), b3, voffB);
            PG8_BAR; PG8_WAIT_L(0); PG8_MMA(0, 1, At, B1); PG8_BAR;
            PG8_LDA(At, 1, 1); PG8_STAGE(PG8_SA(1, 0), a3, voffA);
            PG8_BAR; PG8_WAIT_L(0); PG8_MMA(1, 0, At, B0); PG8_BAR; PG8_SCHED;
            PG8_STAGE(PG8_SB(1, 1), b3 + hstep, voffB);
            PG8_WAIT_V(6); PG8_BAR; PG8_MMA(1, 1, At, B1); PG8_BAR;
        }
        PG8_STAMP();
        if constexpr (!Epi::AFTER_DRAIN) { E(acc, cur, wr, wc, fr, fq); S.done(cur); }
        PG8_STAMP();
        if (!has_next) break;
#pragma unroll
        for (int a = 0; a < 2; ++a)
#pragma unroll
            for (int b = 0; b < 2; ++b)
#pragma unroll
                for (int m = 0; m < 4; ++m)
#pragma unroll
                    for (int n = 0; n < 2; ++n) acc[a][b][m][n] = (f32x4){0.f, 0.f, 0.f, 0.f};
        cur = nxt; cA = nA; cB = nB; ++ui;
    }
    PG8_WAIT_V(0);
    if (wr == 0) PG8_BAR;
    PG8_BAR;
    if constexpr (Epi::AFTER_DRAIN) { E.fused(acc, cur, wr, wc, fr, fq, lds, wid, lane); S.done(cur); }
    PG8_STAMP();
    if (STAMP && wid == 0) { stamps[lane] = lane < nts ? (((unsigned long long)(unsigned)ts_hi << 32) | (unsigned)ts_lo) : 0ull;
        if (lane == 62) stamps[62] = rt_entry; if (lane == 63) stamps[63] = (unsigned long long)wall_clock64(); }
#undef PG8_STAMP
#undef PG8_SA
#undef PG8_SB
#undef PG8_STAGE
#undef PG8_LDA
#undef PG8_LDB
#undef PG8_MMA
#undef PG8_WAIT_V
#undef PG8_WAIT_L
#undef PG8_BAR
#undef PG8_SCHED
}
}
#define LAS __attribute__((address_space(3)))
#define XB_TMO      128
#define XB_XCNT(j)  (256  + 64 * (j))
#define XB_XSUB(j)  (1280 + 64 * (j))
#define XB_XGEN(j)  (2304 + 64 * (j))
#define XB_TOP      3328
#define XB_TOPGEN   3392
#define XCD_BAR_WORDS 3456
#define XB_SPIN_CAP (1u << 18)


__device__ __forceinline__ unsigned xb_ld(unsigned* p)              { return __hip_atomic_load(p, __ATOMIC_RELAXED, __HIP_MEMORY_SCOPE_AGENT); }
__device__ __forceinline__ unsigned xb_add(unsigned* p, unsigned v) { return __hip_atomic_fetch_add(p, v, __ATOMIC_RELAXED, __HIP_MEMORY_SCOPE_AGENT); }
__device__ __forceinline__ unsigned xb_xcc_id() { return (unsigned)__builtin_amdgcn_s_getreg((3 << 11) | 20) & 0xFu; }
#define XB_SPIN(cond, bar) do { unsigned _sp = 0; while (cond) { __builtin_amdgcn_s_sleep(1); \
    if ((++_sp & 255u) == 0u) { if (xb_ld(&(bar)[XB_TMO])) break; if (_sp > XB_SPIN_CAP) { atomicAdd(&(bar)[XB_TMO], 1u); break; } } } } while (0)

struct XcdBarrier {
    unsigned* bar; unsigned x;
    volatile LAS unsigned* st;
};

__device__ __forceinline__ XcdBarrier xcd_barrier_post(unsigned* bar, volatile LAS unsigned* st) {
    XcdBarrier b; b.bar = bar; b.x = xb_xcc_id(); b.st = st;
    if (threadIdx.x == 0) (void)xb_add(&bar[XB_XCNT(b.x)], 1u);
    return b;
}
__device__ __forceinline__ void xcd_barrier_complete(unsigned* bar, unsigned x, unsigned& nloc, unsigned& nx) {
    const unsigned G = gridDim.x * gridDim.y * gridDim.z;
    unsigned sum, cnt, mine, sp = 0u;
    for (;;) {
        sum = 0u; cnt = 0u; mine = 0u;
#pragma unroll
        for (unsigned j = 0; j < 16; ++j) { const unsigned c = xb_ld(&bar[XB_XCNT(j)]); sum += c; cnt += (c > 0u) ? 1u : 0u; mine = (j == x) ? c : mine; }
        if (sum == G) break;
        __builtin_amdgcn_s_sleep(1);
        if ((++sp & 255u) == 0u) { if (xb_ld(&bar[XB_TMO])) break; if (sp > XB_SPIN_CAP) { atomicAdd(&bar[XB_TMO], 1u); break; } }
    }
    nloc = mine > 0u ? mine : 1u; nx = cnt > 0u ? cnt : 1u;
}

__device__ __forceinline__ void xcd_barrier(const XcdBarrier& b) {
    asm volatile("s_waitcnt vmcnt(0)" ::: "memory");
    __syncthreads();
    if (threadIdx.x == 0) {
        unsigned* bar = b.bar;
        __builtin_amdgcn_s_waitcnt(0);
        unsigned nloc = b.st[0], nx = b.st[1];
        if (nloc == 0u) { xcd_barrier_complete(bar, b.x, nloc, nx); b.st[0] = nloc; b.st[1] = nx; }
        const unsigned old = xb_add(&bar[XB_XSUB(b.x)], 1u);
        const unsigned gen = old / nloc;
        if (old + 1u == (gen + 1u) * nloc) {
            __builtin_amdgcn_fence(__ATOMIC_RELEASE, "agent");
            asm volatile("s_waitcnt vmcnt(0)" ::: "memory");
            const unsigned og = xb_add(&bar[XB_TOP], 1u);
            const unsigned tg = og / nx;
            if (og + 1u == (tg + 1u) * nx) xb_add(&bar[XB_TOPGEN], 1u);
            else XB_SPIN(xb_ld(&bar[XB_TOPGEN]) == tg, bar);
            __builtin_amdgcn_fence(__ATOMIC_ACQUIRE, "agent");
            xb_add(&bar[XB_XGEN(b.x)], 1u);
            asm volatile("s_waitcnt vmcnt(0)" ::: "memory");
        } else {
            XB_SPIN(xb_ld(&bar[XB_XGEN(b.x)]) == gen, bar);
            __builtin_amdgcn_fence(__ATOMIC_ACQUIRE, "agent");
            asm volatile("s_waitcnt vmcnt(0)" ::: "memory");
        }
    }
    __syncthreads();
}

using pg8::bf16_t; using pg8::bf16x8; using pg8::f32x4; using pg8::u32x4; using pg8::Unit; using pg8::BM; using pg8::HALF;
typedef float f32x2 __attribute__((ext_vector_type(2)));
typedef unsigned u32x2 __attribute__((ext_vector_type(2)));
typedef _Float16 f16x4 __attribute__((ext_vector_type(4)));

constexpr int D = 1024, FF = 2816, NIN = 1536, GWID = 512, DEPTH = 4;
constexpr int SEQ = 2048, NB = 8, MP = NB * SEQ, MS = 128, MV = MP + MS, MPAD = 16640;
constexpr int NTHR = 512, NWAVES = 8;
constexpr int LDS_STAGE = 131072, LDS_BYTES = LDS_STAGE + 16;
constexpr float LN_EPS = 1e-5f;
constexpr float ALPHA = 1.6817928305074292f;

constexpr size_t W_GU1 = 0, W_D1 = W_GU1 + (size_t)2 * FF * D, W_IN = W_D1 + (size_t)FF * D, W_OUT = W_IN + (size_t)NIN * D,
                 W_GU2 = W_OUT + (size_t)D * D, W_D2 = W_GU2 + (size_t)2 * FF * D, W_LAYER = W_D2 + (size_t)FF * D;
constexpr size_t WS_W = 0;
constexpr size_t WS_SMALL = WS_W + W_LAYER * 2 * DEPTH;
constexpr size_t SMALL_LAYER = 32768 * 2 + 65536;
constexpr size_t WS_X = WS_SMALL + SMALL_LAYER * 2 * DEPTH;
constexpr size_t WS_XN = WS_X + (size_t)MPAD * D * 4;
constexpr size_t WS_HP = WS_XN + (size_t)MPAD * D * 2;
constexpr size_t WS_MIX = WS_HP + (size_t)MPAD * NIN * 4;
constexpr size_t WS_AGG = WS_MIX + (size_t)MPAD * D * 2;
constexpr size_t WS_BAR = WS_AGG + (size_t)NB * 32 * 2 * 512 * 4;
constexpr size_t WS_END = WS_BAR + 16384;
static_assert((size_t)MPAD * FF * 2 <= (size_t)MPAD * NIN * 4, "hid fits in the proj region");
static_assert(WS_END <= 408000000ull, "workspace budget");

constexpr size_t O_Y = 0, O_PH = (size_t)MV * D, O_PC = O_PH + (size_t)DEPTH * NB * GWID, O_PP = O_PC + (size_t)DEPTH * NB * 3 * GWID,
                 O_SH = O_PP + (size_t)DEPTH * NB * 15 * GWID, O_SC = O_SH + (size_t)DEPTH * MS * GWID, O_SP = O_SC + (size_t)DEPTH * MS * 3 * GWID;

struct Params { const float* in[24]; float* out; unsigned char* ws; };
typedef const Params __attribute__((address_space(4))) CParams;
enum { I_XP = 0, I_XS, I_SH, I_SC, I_SP, I_LNG, I_LNB, I_W1G, I_W1U, I_W1D, I_WIN, I_CW, I_CB, I_GAW, I_GAB, I_GXW, I_GXB, I_LAM, I_PW, I_PS, I_WOUT, I_W2G, I_W2U, I_W2D };

__device__ __forceinline__ unsigned pk2(float lo, float hi) { return pg8::cvt_pk_bf16(lo, hi); }
__device__ __forceinline__ bf16_t f2bf(float f) { return (bf16_t)(pg8::cvt_pk_bf16(f, 0.f) & 0xffffu); }
__device__ __forceinline__ float wave_sum(float v) {
#pragma unroll
    for (int o = 1; o < 64; o <<= 1) v += __shfl_xor(v, o);
    return v;
}
__device__ __forceinline__ float sigmoidf_(float x) { return 1.0f / (1.0f + __expf(-x)); }
__device__ __forceinline__ float gelu_tanh(float x) {
    const float z = 0.7978845608028654f * (x + 0.044715f * x * x * x);
    const float e = __expf(2.0f * z);
    const float th = 1.0f - 2.0f / (e + 1.0f);
    return 0.5f * x * (1.0f + th);
}

struct EpiSwiglu {
    static constexpr bool PERM = true, AFTER_DRAIN = false;
    bf16_t* O; int ldc;
    __device__ __forceinline__ void operator()(const f32x4 (&acc)[2][2][4][2], const Unit& u, int wr, int wc, int fr, int fq) const {
        const int row0 = u.pm * BM + wr * 64 + fr, col0 = u.pn * 128 + wc * 32 + 8 * fq;
#pragma unroll
        for (int ai = 0; ai < 2; ++ai)
#pragma unroll
            for (int m = 0; m < 4; ++m) {
                bf16_t* rowp = O + (size_t)(row0 + ai * HALF + m * 16) * ldc + col0;
                float h[8];
#pragma unroll
                for (int n = 0; n < 2; ++n)
#pragma unroll
                    for (int j = 0; j < 4; ++j) { const float g = acc[ai][0][m][n][j], up = acc[ai][1][m][n][j]; h[n * 4 + j] = g * __builtin_amdgcn_rcpf(1.0f + __expf(-g)) * up; }
                u32x4 w; w.x = pk2(h[0], h[1]); w.y = pk2(h[2], h[3]); w.z = pk2(h[4], h[5]); w.w = pk2(h[6], h[7]);
                *(u32x4*)rowp = w;
            }
    }
};
struct EpiResid {
    static constexpr bool PERM = false, AFTER_DRAIN = false;
    float* X; int ldc; float alpha, coef;
    __device__ __forceinline__ void operator()(const f32x4 (&acc)[2][2][4][2], const Unit& u, int wr, int wc, int fr, int fq) const {
        const int row0 = u.pm * BM + wr * 64 + fr, col0 = u.pn * BM + wc * 32 + 4 * fq;
#pragma unroll
        for (int ai = 0; ai < 2; ++ai)
#pragma unroll
            for (int m = 0; m < 4; ++m) { float* rowp = X + (size_t)(row0 + ai * HALF + m * 16) * ldc + col0;
#pragma unroll
                for (int bj = 0; bj < 2; ++bj)
#pragma unroll
                    for (int n = 0; n < 2; ++n) { f32x4* p = (f32x4*)(rowp + bj * HALF + n * 16); const f32x4 v = *p; *p = v * alpha + acc[ai][bj][m][n] * coef; } }
    }
};

__device__ __forceinline__ void transpose_item(const float* W, int K, int N, bf16_t* WT, int mode, LAS float* scr, int item, int lane) {
    const int nblk = N / 32, kb = item / nblk, nb = item % nblk, k0 = 64 * kb, n0 = 32 * nb;
    const int drow0 = mode == 0 ? n0 : (256 * (n0 >> 7) + (n0 & 127) + (mode == 2 ? 128 : 0));
#pragma unroll 8
    for (int i = 0; i < 32; ++i) { const int kk = 2 * i + (lane >> 5); scr[kk * 33 + (lane & 31)] = W[(size_t)(k0 + kk) * N + n0 + (lane & 31)]; }
    asm volatile("s_waitcnt lgkmcnt(0)" ::: "memory");
    const int c = lane & 7;
#pragma unroll
    for (int j = 0; j < 4; ++j) { const int n = (lane >> 3) + 8 * j; const LAS float* s = scr + (8 * c) * 33 + n;
        u32x4 o; o.x = pk2(s[0 * 33], s[1 * 33]); o.y = pk2(s[2 * 33], s[3 * 33]); o.z = pk2(s[4 * 33], s[5 * 33]); o.w = pk2(s[6 * 33], s[7 * 33]);
        *(u32x4*)(WT + (size_t)(drow0 + n) * K + k0 + 8 * c) = o; }
    asm volatile("s_waitcnt lgkmcnt(0)" ::: "memory");
}
__device__ __forceinline__ void prologue(CParams* P, LAS unsigned char* lds, int gw, int NGW, int wave, int lane) {
    LAS float* scr = (LAS float*)(lds + wave * 16384);
    bf16_t* Wb = (bf16_t*)(P->ws + WS_W);
    constexpr int I_G = (D / 64) * (FF / 32), I_DN = (FF / 64) * (D / 32), I_I = (D / 64) * (NIN / 32), I_O = (D / 64) * (D / 32);
    constexpr int PER_LAYER = 4 * I_G + 2 * I_DN + I_I + I_O;
    for (int it = gw; it < PER_LAYER * DEPTH; it += NGW) {
        const int l = it / PER_LAYER; int r = it % PER_LAYER; bf16_t* WL = Wb + (size_t)l * W_LAYER;
        if (r < I_G) { transpose_item(P->in[I_W1G] + (size_t)l * D * FF, D, FF, WL + W_GU1, 1, scr, r, lane); continue; } r -= I_G;
        if (r < I_G) { transpose_item(P->in[I_W1U] + (size_t)l * D * FF, D, FF, WL + W_GU1, 2, scr, r, lane); continue; } r -= I_G;
        if (r < I_DN) { transpose_item(P->in[I_W1D] + (size_t)l * D * FF, FF, D, WL + W_D1, 0, scr, r, lane); continue; } r -= I_DN;
        if (r < I_I) { transpose_item(P->in[I_WIN] + (size_t)l * D * NIN, D, NIN, WL + W_IN, 0, scr, r, lane); continue; } r -= I_I;
        if (r < I_O) { transpose_item(P->in[I_WOUT] + (size_t)l * D * D, D, D, WL + W_OUT, 0, scr, r, lane); continue; } r -= I_O;
        if (r < I_G) { transpose_item(P->in[I_W2G] + (size_t)l * D * FF, D, FF, WL + W_GU2, 1, scr, r, lane); continue; } r -= I_G;
        if (r < I_G) { transpose_item(P->in[I_W2U] + (size_t)l * D * FF, D, FF, WL + W_GU2, 2, scr, r, lane); continue; } r -= I_G;
        transpose_item(P->in[I_W2D] + (size_t)l * D * FF, FF, D, WL + W_D2, 0, scr, r, lane);
    }
    bf16_t* Sm = (bf16_t*)(P->ws + WS_SMALL);
    const int gt = gw * 64 + lane, NGT = NGW * 64;
    for (int o = gt; o < DEPTH * 32768; o += NGT) {
        const int l = o / 32768, rem = o % 32768, h = rem / 4096, j = (rem / 64) % 64, i = rem % 64;
        const size_t src = (size_t)l * 32768 + h * 4096 + i * 64 + j;
        Sm[(size_t)l * SMALL_LAYER + rem] = f2bf(P->in[I_GAW][src]);
        Sm[(size_t)l * SMALL_LAYER + 32768 + rem] = f2bf(P->in[I_GXW][src]);
    }
    for (int o = gt; o < DEPTH * 65536; o += NGT) {
        const int l = o / 65536, rem = o % 65536, g = rem / 16384, j = (rem / 128) % 128, i = rem % 128;
        Sm[(size_t)l * SMALL_LAYER + 65536 + rem] = f2bf(P->in[I_PW][(size_t)l * 65536 + g * 16384 + i * 128 + j]);
    }
    for (int o = gt; o < DEPTH * MS * 2 * (GWID / 4); o += NGT) { const int c4 = o % (GWID / 4), k = (o / (GWID / 4)) % 2, lb = o / (2 * (GWID / 4));
        *(f32x4*)(P->out + O_SC + ((size_t)lb * 3 + k) * GWID + 4 * c4) = *(const f32x4*)(P->in[I_SC] + ((size_t)lb * 3 + k + 1) * GWID + 4 * c4); }
    for (int o = gt; o < DEPTH * MS * 14 * (GWID / 4); o += NGT) { const int c4 = o % (GWID / 4), k = (o / (GWID / 4)) % 14, lb = o / (14 * (GWID / 4));
        *(f32x4*)(P->out + O_SP + ((size_t)lb * 15 + k) * GWID + 4 * c4) = *(const f32x4*)(P->in[I_SP] + ((size_t)lb * 15 + k + 1) * GWID + 4 * c4); }
    float* X = (float*)(P->ws + WS_X); bf16_t* XN = (bf16_t*)(P->ws + WS_XN);
    for (int m = gw; m < MV; m += NGW) {
        const float* src = m < MP ? P->in[I_XP] + (size_t)m * D : P->in[I_XS] + (size_t)(m - MP) * D;
        const f32x4* xr = (const f32x4*)src + lane; f32x4* xo = (f32x4*)(X + (size_t)m * D) + lane; u32x2* o8 = (u32x2*)(XN + (size_t)m * D) + lane;
#pragma unroll
        for (int j = 0; j < 4; ++j) { const f32x4 v = xr[64 * j]; xo[64 * j] = v; u32x2 w; w.x = pk2(v[0], v[1]); w.y = pk2(v[2], v[3]); o8[64 * j] = w; }
    }
}

__device__ __forceinline__ void ln_pass(float* X, bf16_t* XN, float* OUT, const float* g, const float* b, int gw, int NGW, int lane) {
    f32x4 gg[4], bb[4];
#pragma unroll
    for (int j = 0; j < 4; ++j) { gg[j] = ((const f32x4*)g)[lane + 64 * j]; bb[j] = ((const f32x4*)b)[lane + 64 * j]; }
    for (int m = gw; m < MV; m += NGW) {
        const f32x4* xr = (const f32x4*)(X + (size_t)m * D) + lane;
        f32x4 v[4]; float s = 0.f;
#pragma unroll
        for (int j = 0; j < 4; ++j) { v[j] = xr[64 * j]; s += (v[j][0] + v[j][1]) + (v[j][2] + v[j][3]); }
        const float mean = wave_sum(s) * (1.f / D); float s2 = 0.f;
#pragma unroll
        for (int j = 0; j < 4; ++j) { v[j] = v[j] - mean; s2 += (v[j][0] * v[j][0] + v[j][1] * v[j][1]) + (v[j][2] * v[j][2] + v[j][3] * v[j][3]); }
        const float rstd = 1.0f / sqrtf(wave_sum(s2) * (1.f / D) + LN_EPS);
        f32x4* xo = (f32x4*)((OUT ? OUT : X) + (size_t)m * D) + lane; u32x2* o8 = (u32x2*)(XN + (size_t)m * D) + lane;
#pragma unroll
        for (int j = 0; j < 4; ++j) { const f32x4 y = v[j] * rstd * gg[j] + bb[j]; xo[64 * j] = y; u32x2 w; w.x = pk2(y[0], y[1]); w.y = pk2(y[2], y[3]); o8[64 * j] = w; }
    }
}

constexpr int XCS = 520;
constexpr int XC_OFF = 0, R_OFF = 32 * XCS * 2, I_OFF = 2 * 32 * XCS * 2;

__device__ __forceinline__ void gates_mfma(LAS unsigned char* lds, const bf16_t* WaT, const bf16_t* WxT, const float* ba, const float* bx, int h, int fr, int fq) {
    bf16x8 A[2][2];
#pragma unroll
    for (int mb = 0; mb < 2; ++mb)
#pragma unroll
        for (int kb = 0; kb < 2; ++kb) A[mb][kb] = *(const LAS bf16x8*)(lds + XC_OFF + ((mb * 16 + fr) * XCS + 64 * h + kb * 32 + 8 * fq) * 2);
#pragma unroll
    for (int gate = 0; gate < 2; ++gate) {
        const bf16_t* W = (gate ? WxT : WaT) + h * 4096; const float* bias = (gate ? bx : ba) + 64 * h; const int ooff = gate ? I_OFF : R_OFF;
#pragma unroll
        for (int nb = 0; nb < 4; ++nb) {
            const bf16x8 B0 = *(const bf16x8*)(W + (nb * 16 + fr) * 64 + 8 * fq), B1 = *(const bf16x8*)(W + (nb * 16 + fr) * 64 + 32 + 8 * fq);
            const f32x4 bv = *(const f32x4*)(bias + nb * 16 + 4 * fq);
#pragma unroll
            for (int mb = 0; mb < 2; ++mb) {
                f32x4 acc = (f32x4){0.f, 0.f, 0.f, 0.f};
                acc = __builtin_amdgcn_mfma_f32_16x16x32_bf16(B0, A[mb][0], acc, 0, 0, 0);
                acc = __builtin_amdgcn_mfma_f32_16x16x32_bf16(B1, A[mb][1], acc, 0, 0, 0);
                acc = acc + bv;
                f16x4 hv; hv[0] = (_Float16)sigmoidf_(acc[0]); hv[1] = (_Float16)sigmoidf_(acc[1]); hv[2] = (_Float16)sigmoidf_(acc[2]); hv[3] = (_Float16)sigmoidf_(acc[3]);
                *(LAS f16x4*)(lds + ooff + ((mb * 16 + fr) * XCS + 64 * h + nb * 16 + 4 * fq) * 2) = hv;
            }
        }
    }
}
template <int NMB>
__device__ __forceinline__ void pool_mfma(LAS unsigned char* lds, const bf16_t* PWT, const float* pscale, bf16_t* mixrow, int w, int fr, int fq) {
    const int g = w >> 1, half = w & 1;
    f32x4 acc[NMB][4];
#pragma unroll
    for (int mb = 0; mb < NMB; ++mb)
#pragma unroll
        for (int nb = 0; nb < 4; ++nb) acc[mb][nb] = (f32x4){0.f, 0.f, 0.f, 0.f};
#pragma unroll
    for (int kb = 0; kb < 4; ++kb) {
        bf16x8 A[NMB];
#pragma unroll
        for (int mb = 0; mb < NMB; ++mb) A[mb] = *(const LAS bf16x8*)(lds + ((mb * 16 + fr) * XCS + 128 * g + kb * 32 + 8 * fq) * 2);
#pragma unroll
        for (int nb = 0; nb < 4; ++nb) {
            const bf16x8 B = *(const bf16x8*)(PWT + ((size_t)g * 128 + 64 * half + nb * 16 + fr) * 128 + kb * 32 + 8 * fq);
#pragma unroll
            for (int mb = 0; mb < NMB; ++mb) acc[mb][nb] = __builtin_amdgcn_mfma_f32_16x16x32_bf16(B, A[mb], acc[mb][nb], 0, 0, 0);
        }
    }
#pragma unroll
    for (int nb = 0; nb < 4; ++nb) {
        const int ch = 128 * g + 64 * half + nb * 16 + 4 * fq; const f32x4 sc = *(const f32x4*)(pscale + ch);
#pragma unroll
        for (int mb = 0; mb < NMB; ++mb) { const f32x4 v = acc[mb][nb] * sc; u32x2 o; o.x = pk2(v[0], v[1]); o.y = pk2(v[2], v[3]);
            *(u32x2*)(mixrow + (size_t)(mb * 16 + fr) * D + GWID + ch) = o; }
    }
}
template <int W>
__device__ __forceinline__ void pool_prompt_thread(const float* UP, int t0, LAS bf16_t* PL, int c) {
    float hist[W - 1], v[64]; float s = 0.f;
#pragma unroll
    for (int k = 0; k < W - 1; ++k) hist[k] = (t0 > 0) ? (UP + (k - (W - 1)) * NIN)[c] : 0.f;
#pragma unroll
    for (int t = 0; t < 64; ++t) v[t] = (UP + t * NIN)[c];
#pragma unroll
    for (int k = 0; k < W - 1; ++k) s += hist[k];
#pragma unroll
    for (int t = 0; t < 64; ++t) {
        s += v[t];
        const float rc = (t >= W - 1 || t0 > 0) ? (1.0f / (float)W) : (1.0f / (float)(t + 1));
        PL[t * XCS + c] = f2bf(s * rc - v[t]);
        s -= (t - W + 1 >= 0) ? v[t - W + 1 >= 0 ? t - W + 1 : 0] : hist[t < W - 1 ? t : 0];
    }
}
template <int W>
__device__ __forceinline__ void pool_sample_thread(const float* UP, const float* SPs, float* SPo, LAS bf16_t* PL, int c) {
    float v[32];
#pragma unroll
    for (int t = 0; t < 32; ++t) v[t] = (UP + (size_t)t * NIN)[c];
#pragma unroll
    for (int t0 = 0; t0 < 32; t0 += 4) {
        float q[4][W - 1];
#pragma unroll
        for (int t = 0; t < 4; ++t)
#pragma unroll
            for (int k = 0; k < W - 1; ++k) q[t][k] = (SPs + ((size_t)(t0 + t) * 15 + (16 - W) + k) * GWID)[c];
#pragma unroll
        for (int t = 0; t < 4; ++t) { float s = v[t0 + t];
#pragma unroll
            for (int k = 0; k < W - 1; ++k) s += q[t][k];
            PL[(t0 + t) * XCS + c] = f2bf(s * (1.0f / (float)W) - v[t0 + t]); }
    }
#pragma unroll
    for (int t = 0; t < 32; ++t) (SPo + ((size_t)t * 15 + 14) * GWID)[c] = v[t];
}

struct MixW {
    const float *cw, *cb, *gab, *gxb, *lam, *psc; const bf16_t *GAT, *GXT, *PWT;
};

__global__ void __launch_bounds__(NTHR, 2) fwd_megakernel(Params p) {
    extern __shared__ __attribute__((aligned(16))) unsigned char lds_raw[];
    LAS unsigned char* lds = (LAS unsigned char*)lds_raw;
    cg::grid_group grid = cg::this_grid();
    const int G0 = gridDim.x, bid0 = blockIdx.x;

    if (threadIdx.x == 0) { ((LAS unsigned*)(lds + LDS_STAGE))[0] = 0u; ((LAS unsigned*)(lds + LDS_STAGE))[1] = 0u; }
    __syncthreads();
    (void)xcd_barrier_post((unsigned*)(((CParams*)__builtin_amdgcn_kernarg_segment_ptr())->ws + WS_BAR), (volatile LAS unsigned*)(lds + LDS_STAGE));
#define GSYNC() do { XcdBarrier b_; b_.bar = (unsigned*)(ws + WS_BAR); b_.x = xb_xcc_id(); b_.st = (volatile LAS unsigned*)(lds + LDS_STAGE); xcd_barrier(b_); } while (0)
    { const int tid = threadIdx.x, lane = tid & 63, wave = __builtin_amdgcn_readfirstlane(tid >> 6);
      prologue((CParams*)__builtin_amdgcn_kernarg_segment_ptr(), lds, bid0 * NWAVES + wave, G0 * NWAVES, wave, lane); }
    grid.sync();

    constexpr int NK = 10;
#ifdef TIME_CLASS
    unsigned long long t_acc = 0;
#endif
    for (int ph = 0; ph < DEPTH * NK; ++ph) {
        const int l = ph / NK, kind = ph % NK;
#ifdef TIME_CLASS
        const unsigned long long t_beg = __builtin_amdgcn_s_memrealtime();
#endif
        int G = G0, bid = bid0; asm volatile("" : "+s"(G), "+s"(bid));
        const int NGW = G * NWAVES;
        int tid = threadIdx.x; asm volatile("" : "+v"(tid));
        const int lane = tid & 63, wave = __builtin_amdgcn_readfirstlane(tid >> 6), fr = lane & 15, fq = lane >> 4, gw = bid * NWAVES + wave;
        CParams* P = (CParams*)__builtin_amdgcn_kernarg_segment_ptr(); asm volatile("" : "+s"(P));
        unsigned char* const ws = P->ws;
        float* X = (float*)(ws + WS_X); bf16_t* XN = (bf16_t*)(ws + WS_XN); bf16_t* HID = (bf16_t*)(ws + WS_HP); float* PROJ = (float*)(ws + WS_HP);
        bf16_t* MIX = (bf16_t*)(ws + WS_MIX); float* AGG = (float*)(ws + WS_AGG);
        const bf16_t* Wb = (const bf16_t*)(ws + WS_W); const bf16_t* Sm = (const bf16_t*)(ws + WS_SMALL);
        const bf16_t* WL = Wb + (size_t)l * W_LAYER;
        if (kind == 0 || kind == 7) {
            pg8::Gemm g{XN, WL + (kind == 0 ? W_GU1 : W_GU2), MPAD, 2 * FF, D}; pg8::StaticOrder S; S.init(MPAD, 2 * FF, G, bid);
            EpiSwiglu E{HID, FF};
            pg8::gemm_phase<EpiSwiglu, pg8::StaticOrder>(lds, g, S, E, nullptr);
        } else if (kind == 1 || kind == 8 || kind == 5) {
            const bool wo = (kind == 5);
            pg8::Gemm g{wo ? MIX : HID, WL + (wo ? W_OUT : (kind == 1 ? W_D1 : W_D2)), MPAD, D, wo ? D : FF}; pg8::StaticOrder S; S.init(MPAD, D, G, bid);
            EpiResid E{X, D, ALPHA, wo ? 1.0f : 0.5f};
            pg8::gemm_phase<EpiResid, pg8::StaticOrder>(lds, g, S, E, nullptr);
        } else if (kind == 3) {
            pg8::Gemm g{XN, WL + W_IN, MPAD, NIN, D}; pg8::StaticOrder S; S.init(MPAD, NIN, G, bid);
            pg8::EpiF32 E{PROJ, NIN, nullptr};
            pg8::gemm_phase<pg8::EpiF32, pg8::StaticOrder>(lds, g, S, E, nullptr);
        } else if (kind == 2 || kind == 6 || kind == 9) {
            const int which = kind == 2 ? 0 : (kind == 6 ? 1 : 2);
            const bool fin = (l == DEPTH - 1 && which == 2);
            ln_pass(X, XN, fin ? P->out + O_Y : nullptr, P->in[I_LNG] + (size_t)(l * 3 + which) * D, P->in[I_LNB] + (size_t)(l * 3 + which) * D, gw, NGW, lane);
        } else {
            MixW mw; mw.cw = P->in[I_CW] + (size_t)l * 4 * GWID; mw.cb = P->in[I_CB] + (size_t)l * GWID; mw.gab = P->in[I_GAB] + (size_t)l * GWID; mw.gxb = P->in[I_GXB] + (size_t)l * GWID;
            mw.lam = P->in[I_LAM] + (size_t)l * GWID; mw.psc = P->in[I_PS] + (size_t)l * GWID;
            mw.GAT = Sm + (size_t)l * SMALL_LAYER; mw.GXT = mw.GAT + 32768; mw.PWT = mw.GAT + 65536;
            const int c = tid;
            const bool has = bid < NB * 32;
            const int b = bid >> 5, j = bid & 31, t0 = j * 64; const size_t row0 = (size_t)b * SEQ + t0;
            const float cw0 = mw.cw[c], cw1 = mw.cw[GWID + c], cw2 = mw.cw[2 * GWID + c], cw3 = mw.cw[3 * GWID + c], cbv = mw.cb[c];
            const float lamv = mw.lam[c]; const float k8 = -8.0f * log1pf(__expf(-lamv));
            if (has) {
                const float* UP = PROJ + row0 * NIN + 2 * GWID; LAS bf16_t* PL = (LAS bf16_t*)lds;
                const int grp = wave >> 1;
                if (grp == 0) pool_prompt_thread<2>(UP, t0, PL, c); else if (grp == 1) pool_prompt_thread<4>(UP, t0, PL, c);
                else if (grp == 2) pool_prompt_thread<8>(UP, t0, PL, c); else pool_prompt_thread<16>(UP, t0, PL, c);
                if (j == 31) { float* o = P->out + O_PP + ((size_t)(l * NB + b) * 15) * GWID; float q[15];
#pragma unroll
                    for (int k = 0; k < 15; ++k) q[k] = (UP + (49 + k) * NIN)[c];
#pragma unroll
                    for (int k = 0; k < 15; ++k) (o + k * GWID)[c] = q[k]; }
                __syncthreads();
                pool_mfma<4>(lds, mw.PWT, mw.psc, MIX + row0 * D, wave, fr, fq);
                __syncthreads();
            }
            for (int pass = 0; pass < 2; ++pass) {
                if (has) {
                    float h = 0.f, cum = 1.f;
                    if (pass == 1) {
#pragma unroll 8
                        for (int i = 0; i < j; ++i) { const float A_ = (AGG + ((size_t)(b * 32 + i) * 2 + 0) * GWID)[c], H_ = (AGG + ((size_t)(b * 32 + i) * 2 + 1) * GWID)[c]; h = A_ * h + H_; }
                    }
                    const float* U = PROJ + row0 * NIN; bf16_t* mo = MIX + row0 * D;
                    float p0 = 0.f, p1 = 0.f, p2 = 0.f;
                    if (j > 0) { p0 = (U - 3 * NIN)[c]; p1 = (U - 2 * NIN)[c]; p2 = (U - 1 * NIN)[c]; }
                    for (int s = 0; s < 2; ++s) {
                        float xc[32], gt[32];
                        { float u[32];
#pragma unroll
                          for (int t = 0; t < 32; ++t) u[t] = (U + (s * 32 + t) * NIN)[c];
#pragma unroll
                          for (int t = 0; t < 32; ++t) gt[t] = (pass == 1) ? (U + (s * 32 + t) * NIN + GWID)[c] : 0.f;
#pragma unroll
                          for (int t = 0; t < 32; ++t) { const float v = u[t]; xc[t] = cbv + cw0 * p0 + cw1 * p1 + cw2 * p2 + cw3 * v; p0 = p1; p1 = p2; p2 = v;
                              ((LAS bf16_t*)(lds + XC_OFF))[t * XCS + c] = f2bf(xc[t]); } }
                        __syncthreads();
                        gates_mfma(lds, mw.GAT, mw.GXT, mw.gab, mw.gxb, wave, fr, fq);
                        __syncthreads();
#pragma unroll
                        for (int t = 0; t < 32; ++t) {
                            const float r = (float)((const LAS _Float16*)(lds + R_OFF))[t * XCS + c], ig = (float)((const LAS _Float16*)(lds + I_OFF))[t * XCS + c];
                            const float la = r * k8, a = __expf(la), mult = sqrtf(-expm1f(2.0f * la)), uu = mult * (ig * xc[t]);
                            h = a * h + uu; cum *= a;
                            if (pass == 1) (mo + (size_t)(s * 32 + t) * D)[c] = f2bf(h * gelu_tanh(gt[t]));
                        }
                        __syncthreads();
                    }
                    if (pass == 0) {
                        (AGG + ((size_t)(b * 32 + j) * 2 + 0) * GWID)[c] = cum; (AGG + ((size_t)(b * 32 + j) * 2 + 1) * GWID)[c] = h;
                        if (j == 31) { float* o = P->out + O_PC + ((size_t)(l * NB + b) * 3) * GWID; o[c] = p0; (o + GWID)[c] = p1; (o + 2 * GWID)[c] = p2; }
                    } else if (j == 31) (P->out + O_PH + (size_t)(l * NB + b) * GWID)[c] = h;
                }
                if (pass == 0) GSYNC();
            }
            if (bid >= G - 4) {
                const int b0 = (bid - (G - 4)) * 32; const size_t srow0 = (size_t)MP + b0;
                __syncthreads();
                {
                    const float* UP = PROJ + srow0 * NIN + 2 * GWID; LAS bf16_t* PL = (LAS bf16_t*)lds;
                    const float* SPs = P->in[I_SP] + ((size_t)(l * MS + b0) * 15) * GWID; float* SPo = P->out + O_SP + ((size_t)(l * MS + b0) * 15) * GWID;
                    const int grp = wave >> 1;
                    if (grp == 0) pool_sample_thread<2>(UP, SPs, SPo, PL, c); else if (grp == 1) pool_sample_thread<4>(UP, SPs, SPo, PL, c);
                    else if (grp == 2) pool_sample_thread<8>(UP, SPs, SPo, PL, c); else pool_sample_thread<16>(UP, SPs, SPo, PL, c);
                    __syncthreads();
                    pool_mfma<2>(lds, mw.PWT, mw.psc, MIX + srow0 * D, wave, fr, fq);
                    __syncthreads();
                }
                {
                    float xc[32], h0[32], gt[32];
                    { float u[32];
#pragma unroll
                      for (int t = 0; t < 32; ++t) u[t] = (PROJ + (srow0 + t) * NIN)[c];
#pragma unroll
                      for (int t = 0; t < 32; ++t) xc[t] = cbv;
#pragma unroll
                      for (int k = 0; k < 3; ++k) { float sk[32]; const float wk = k == 0 ? cw0 : (k == 1 ? cw1 : cw2);
#pragma unroll
                          for (int t = 0; t < 32; ++t) sk[t] = (P->in[I_SC] + ((size_t)(l * MS + b0 + t) * 3 + k) * GWID)[c];
#pragma unroll
                          for (int t = 0; t < 32; ++t) xc[t] += wk * sk[t]; }
#pragma unroll
                      for (int t = 0; t < 32; ++t) { xc[t] += cw3 * u[t]; ((LAS bf16_t*)(lds + XC_OFF))[t * XCS + c] = f2bf(xc[t]); }
#pragma unroll
                      for (int t = 0; t < 32; ++t) (P->out + O_SC + ((size_t)(l * MS + b0 + t) * 3 + 2) * GWID)[c] = u[t]; }
#pragma unroll
                    for (int t = 0; t < 32; ++t) { h0[t] = (P->in[I_SH] + (size_t)(l * MS + b0 + t) * GWID)[c]; gt[t] = (PROJ + (srow0 + t) * NIN + GWID)[c]; }
                    __syncthreads();
                    gates_mfma(lds, mw.GAT, mw.GXT, mw.gab, mw.gxb, wave, fr, fq);
                    __syncthreads();
#pragma unroll
                    for (int t = 0; t < 32; ++t) {
                        const float r = (float)((const LAS _Float16*)(lds + R_OFF))[t * XCS + c], ig = (float)((const LAS _Float16*)(lds + I_OFF))[t * XCS + c];
                        const float la = r * k8, a = __expf(la), mult = sqrtf(-expm1f(2.0f * la)), uu = mult * (ig * xc[t]);
                        const float hh = a * h0[t] + uu;
                        (P->out + O_SH + (size_t)(l * MS + b0 + t) * GWID)[c] = hh;
                        (MIX + (srow0 + t) * D)[c] = f2bf(hh * gelu_tanh(gt[t]));
                    }
                    __syncthreads();
                }
            }
        }
        if (ph != DEPTH * NK - 1) GSYNC();
#ifdef TIME_CLASS
        { const int cls = (kind == 0 || kind == 7) ? 0 : (kind == 1 || kind == 8) ? 1 : (kind == 3 || kind == 5) ? 2 : (kind == 4) ? 4 : 3;
          if (cls == TIME_CLASS) t_acc += __builtin_amdgcn_s_memrealtime() - t_beg; }
#endif
    }
#ifdef TIME_CLASS
    if (blockIdx.x == 0) { const unsigned long long t0 = __builtin_amdgcn_s_memrealtime(); while (__builtin_amdgcn_s_memrealtime() - t0 < t_acc) __builtin_amdgcn_s_sleep(8); }
#endif
}

extern "C" void kernel_launch(void* const* d_in, const int* in_sizes, int n_in, void* d_out, int out_size, void* d_ws, size_t ws_size, hipStream_t stream) {
    static int grid_blocks = 0;
    if (!grid_blocks) {
        int dev = 0, cus = 0, per_cu = 0;
        hipGetDevice(&dev);
        hipDeviceGetAttribute(&cus, hipDeviceAttributeMultiprocessorCount, dev);
        hipFuncSetAttribute((const void*)fwd_megakernel, hipFuncAttributeMaxDynamicSharedMemorySize, LDS_BYTES);
        hipOccupancyMaxActiveBlocksPerMultiprocessor(&per_cu, (const void*)fwd_megakernel, NTHR, LDS_BYTES);
        if (per_cu < 1) per_cu = 1;
        grid_blocks = cus * per_cu;
        if (grid_blocks > 256) grid_blocks = 256;
        if (ws_size < WS_END) fprintf(stderr, "kernel_launch: workspace too small: %zu < %zu\n", ws_size, (size_t)WS_END);
    }
    Params p{};
    for (int i = 0; i < 24; ++i) p.in[i] = (const float*)d_in[i];
    p.out = (float*)d_out; p.ws = (unsigned char*)d_ws;
    (void)hipMemsetAsync((unsigned char*)d_ws + WS_BAR, 0, 16384, stream);
    void* args[] = {&p};
    hipError_t e = hipLaunchCooperativeKernel((const void*)fwd_megakernel, dim3(grid_blocks), dim3(NTHR), args, LDS_BYTES, stream);
    if (e != hipSuccess) fprintf(stderr, "cooperative launch failed: %s (grid %d)\n", hipGetErrorString(e), grid_blocks);
}
```

```cpp
#include <hip/hip_runtime.h>
#include <hip/hip_cooperative_groups.h>
#include <cstdio>
namespace cg = cooperative_groups;
namespace pg8 {
#define PG8_LAS __attribute__((address_space(3)))
typedef unsigned short bf16_t;
typedef short bf16x8 __attribute__((ext_vector_type(8)));
typedef float f32x4 __attribute__((ext_vector_type(4)));
typedef unsigned u32x4 __attribute__((ext_vector_type(4)));
constexpr int BM = 256, BK = 64, HALF = 128, HTB = HALF * BK * 2  , STAGE_BYTES = 8 * HTB, NXCD = 8, WGM = 8;

__host__ __device__ __forceinline__ int lds_byte(int r, int c) { const int st = (r >> 4) * 2 + (c >> 5), rr = r & 15, cc = c & 31, ob = rr * 64 + cc * 2; return st * 1024 + (ob ^ (((ob >> 9) & 1) << 5)); }
__host__ __device__ __forceinline__ void stage_rc(int b, int& R, int& C) { const int st = b / 1024, sb = b % 1024, swz = sb ^ (((sb >> 9) & 1) << 5); R = (st >> 1) * 16 + swz / 64; C = (st & 1) * 32 + (swz % 64) / 2; }
__host__ __device__ __forceinline__ int perm32(int rho) { const int n = rho >> 4, i = rho & 15; return 8 * (i >> 2) + 4 * n + (i & 3); }

struct Unit { int pm, pn; };
struct Gemm { const bf16_t* A; const bf16_t* Bt; int M, N, K; };

struct StaticOrder {
    int nM, nN, nwg, G, c;
    __host__ __device__ void init(int M, int N, int G_, int c_) { nM = M / BM; nN = N / BM; nwg = nM * nN; G = G_; c = c_; }
    __host__ __device__ bool next(int i, Unit& u) const {
        const long L = (long)i * G + c; if (L >= nwg) return false;
        int wgid = (int)L; { const int q = nwg / NXCD, r = nwg % NXCD, xcd = wgid % NXCD, off = wgid / NXCD; wgid = (xcd < r ? xcd * (q + 1) : r * (q + 1) + (xcd - r) * q) + off; }
        const int nig = WGM * nN, gid = wgid / nig, fm = gid * WGM, gsz = (nM - fm) < WGM ? (nM - fm) : WGM;
        u.pm = fm + ((wgid % nig) % gsz); u.pn = (wgid % nig) / gsz; return true;
    }
    __device__ __forceinline__ void a_ready(const Unit&) const {}
    __device__ __forceinline__ void done(const Unit&) const {}
};
__device__ __forceinline__ unsigned cvt_pk_bf16(float lo, float hi) { unsigned r; asm volatile("v_cvt_pk_bf16_f32 %0, %1, %2" : "=v"(r) : "v"(lo), "v"(hi)); return r; }
typedef float f32x2 __attribute__((ext_vector_type(2)));
struct EpiF32 {
    static constexpr bool PERM = false, AFTER_DRAIN = false;
    float* C; int ldc; const float* bias;
    __device__ __forceinline__ void operator()(const f32x4 (&acc)[2][2][4][2], const Unit& u, int wr, int wc, int fr, int fq) const {
        const int row0 = u.pm * BM + wr * 64 + fr, col0 = u.pn * BM + wc * 32 + 4 * fq;
        f32x4 bv[2][2];
#pragma unroll
        for (int bj = 0; bj < 2; ++bj)
#pragma unroll
            for (int n = 0; n < 2; ++n) bv[bj][n] = bias ? *(const f32x4*)(bias + col0 + bj * HALF + n * 16) : (f32x4){0.f, 0.f, 0.f, 0.f};
#pragma unroll
        for (int ai = 0; ai < 2; ++ai)
#pragma unroll
            for (int m = 0; m < 4; ++m) { float* rowp = C + (size_t)(row0 + ai * HALF + m * 16) * ldc + col0;
#pragma unroll
                for (int bj = 0; bj < 2; ++bj)
#pragma unroll
                    for (int n = 0; n < 2; ++n) *(f32x4*)(rowp + bj * HALF + n * 16) = acc[ai][bj][m][n] + bv[bj][n]; }
    }
};
template <class Epi, class Sched, bool STAMP = false>
__device__ __forceinline__ void gemm_phase(PG8_LAS unsigned char* lds, const Gemm g, const Sched& S, const Epi& E, unsigned long long* stamps) {
    int tid_l = threadIdx.x; asm volatile("" : "+v"(tid_l));
    const int tid = tid_l, wid = __builtin_amdgcn_readfirstlane(tid >> 6), lane = tid & 63, wr = wid >> 2, wc = wid & 3, fr = lane & 15, fq = lane >> 4;
    const int K = g.K, nt = K / BK;
    int ts_lo = 0, ts_hi = 0, nts = 0; const unsigned long long rt_entry = STAMP ? (unsigned long long)wall_clock64() : 0ull;
#define PG8_STAMP() do { if (STAMP && wid == 0 && nts < 64) { const unsigned long long _c = (unsigned long long)clock64(); \
        ts_lo = (lane == nts) ? (int)(unsigned)_c : ts_lo; ts_hi = (lane == nts) ? (int)(unsigned)(_c >> 32) : ts_hi; ++nts; } } while (0)
    PG8_STAMP();
    unsigned voffA[2], voffB[2];
#pragma unroll
    for (int i = 0; i < 2; ++i) { int R, C; stage_rc(tid * 16 + i * 8192, R, C); const int Rb = Epi::PERM ? ((R & ~31) + perm32(R & 31)) : R;
        voffA[i] = (unsigned)(R * K + C) * 2u; voffB[i] = (unsigned)(Rb * K + C) * 2u; }
    const size_t kstep = (size_t)(BK * 2);
    const size_t hstep = (size_t)HALF * K * 2;
    const size_t tstep = 2 * hstep;
    const unsigned ldsw = (unsigned)wid * 1024u;
    const int aoff = lds_byte(wr * 64 + fr, fq * 8), boff = lds_byte(wc * 32 + fr, fq * 8);
#define PG8_SA(b, h) (((b) * 2 + (h)) * HTB)
#define PG8_SB(b, h) ((4 + (b) * 2 + (h)) * HTB)
#define PG8_STAGE(bufoff, gbase, voff) do { _Pragma("unroll") for (int _i = 0; _i < 2; ++_i) \
        __builtin_amdgcn_global_load_lds((const unsigned*)((const char*)(gbase) + (voff)[_i]), (PG8_LAS unsigned*)(lds + (bufoff) + ldsw + _i * 8192), 16, 0, 0); } while (0)
#define PG8_LDA(dst, b, h) do { _Pragma("unroll") for (int m = 0; m < 4; ++m) _Pragma("unroll") for (int k = 0; k < 2; ++k) dst[m][k] = *(const PG8_LAS bf16x8*)(lds + PG8_SA(b, h) + aoff + m * 2048 + k * 1024); } while (0)
#define PG8_LDB(dst, b, h) do { _Pragma("unroll") for (int n = 0; n < 2; ++n) _Pragma("unroll") for (int k = 0; k < 2; ++k) dst[n][k] = *(const PG8_LAS bf16x8*)(lds + PG8_SB(b, h) + boff + n * 2048 + k * 1024); } while (0)
#define PG8_MMA(ai, bj, At, Bt) do { __builtin_amdgcn_s_setprio(1); _Pragma("unroll") for (int m = 0; m < 4; ++m) _Pragma("unroll") for (int n = 0; n < 2; ++n) _Pragma("unroll") for (int k = 0; k < 2; ++k) \
        acc[ai][bj][m][n] = __builtin_amdgcn_mfma_f32_16x16x32_bf16(Bt[n][k], At[m][k], acc[ai][bj][m][n], 0, 0, 0); __builtin_amdgcn_s_setprio(0); } while (0)
#define PG8_WAIT_V(n) asm volatile("s_waitcnt vmcnt(" #n ")" ::: "memory")
#define PG8_WAIT_L(n) asm volatile("s_waitcnt lgkmcnt(" #n ")" ::: "memory")
#define PG8_BAR __builtin_amdgcn_s_barrier()
#define PG8_SCHED __builtin_amdgcn_sched_barrier(0)
    Unit cur, nxt; int ui = 0;
    if (!S.next(0, cur)) return;
    f32x4 acc[2][2][4][2];
#pragma unroll
    for (int a = 0; a < 2; ++a)
#pragma unroll
        for (int b = 0; b < 2; ++b)
#pragma unroll
            for (int m = 0; m < 4; ++m)
#pragma unroll
                for (int n = 0; n < 2; ++n) acc[a][b][m][n] = (f32x4){0.f, 0.f, 0.f, 0.f};
    bf16x8 At[4][2], B0[2][2], B1[2][2];
    const char* cA = (const char*)g.A + (size_t)cur.pm * tstep; const char* cB = (const char*)g.Bt + (size_t)cur.pn * tstep;
    S.a_ready(cur);
    PG8_STAGE(PG8_SB(0, 0), cB, voffB); PG8_STAGE(PG8_SA(0, 0), cA, voffA); PG8_STAGE(PG8_SB(0, 1), cB + hstep, voffB); PG8_STAGE(PG8_SA(0, 1), cA + hstep, voffA);
    if (wr == 1) PG8_BAR;
    PG8_WAIT_V(4); PG8_BAR;
    PG8_STAGE(PG8_SB(1, 0), cB + kstep, voffB); PG8_STAGE(PG8_SA(1, 0), cA + kstep, voffA); PG8_STAGE(PG8_SB(1, 1), cB + hstep + kstep, voffB);
    PG8_WAIT_V(6); PG8_BAR;
    PG8_STAMP();
    for (;;) {
        const bool has_next = S.next(ui + 1, nxt);
        const char* nA = has_next ? (const char*)g.A + (size_t)nxt.pm * tstep : cA; const char* nB = has_next ? (const char*)g.Bt + (size_t)nxt.pn * tstep : cB;
        for (int t = 0; t < nt; t += 2) {
            const bool last = (t == nt - 2);
            const char* a1 = cA + (size_t)(t + 1) * kstep;
            const char* a2 = last ? nA : cA + (size_t)(t + 2) * kstep; const char* b2 = last ? nB : cB + (size_t)(t + 2) * kstep;
            const char* a3 = a2 + kstep; const char* b3 = b2 + kstep;
            if (last && has_next) S.a_ready(nxt);
            PG8_LDB(B0, 0, 0); PG8_SCHED; PG8_LDA(At, 0, 0); PG8_STAGE(PG8_SA(1, 1), a1 + hstep, voffA);
            PG8_WAIT_L(8); PG8_BAR; PG8_WAIT_L(0); PG8_MMA(0, 0, At, B0); PG8_BAR; PG8_SCHED;
            PG8_LDB(B1, 0, 1); PG8_STAGE(PG8_SB(0, 0), b2, voffB);
            PG8_BAR; PG8_WAIT_L(0); PG8_MMA(0, 1, At, B1); PG8_BAR;
            PG8_LDA(At, 0, 1); PG8_STAGE(PG8_SA(0, 0), a2, voffA);
            PG8_BAR; PG8_WAIT_L(0); PG8_MMA(1, 0, At, B0); PG8_BAR; PG8_SCHED;
            PG8_STAGE(PG8_SB(0, 1), b2 + hstep, voffB);
            PG8_WAIT_V(6); PG8_BAR; PG8_MMA(1, 1, At, B1); PG8_BAR;
            PG8_LDB(B0, 1, 0); PG8_SCHED; PG8_LDA(At, 1, 0); PG8_STAGE(PG8_SA(0, 1), a2 + hstep, voffA);
            PG8_WAIT_L(8); PG8_BAR; PG8_WAIT_L(0); PG8_MMA(0, 0, At, B0); PG8_BAR; PG8_SCHED;
            PG8_LDB(B1, 1, 1); PG8_STAGE(PG8_SB(1, 0), b3, voffB);
            PG8_BAR; PG8_WAIT_L(0); PG8_MMA(0, 1, At, B1); PG8_BAR;
            PG8_LDA(At, 1, 1); PG8_STAGE(PG8_SA(1, 0), a3, voffA);
            PG8_BAR; PG8_WAIT_L(0); PG8_MMA(1, 0, At, B0); PG8_BAR; PG8_SCHED;
            PG8_STAGE(PG8_SB(1, 1), b3 + hstep, voffB);
            PG8_WAIT_V(6); PG8_BAR; PG8_MMA(1, 1, At, B1); PG8_BAR;
        }
        PG8_STAMP();
        if constexpr (!Epi::AFTER_DRAIN) { E(acc, cur, wr, wc, fr, fq); S.done(cur); }
        PG8_STAMP();
        if (!has_next) break;
#pragma unroll
        for (int a = 0; a < 2; ++a)
#pragma unroll
            for (int b = 0; b < 2; ++b)
#pragma unroll
                for (int m = 0; m < 4; ++m)
#pragma unroll
                    for (int n = 0; n < 2; ++n) acc[a][b][m][n] = (f32x4){0.f, 0.f, 0.f, 0.f};
        cur = nxt; cA = nA; cB = nB; ++ui;
    }
    PG8_WAIT_V(0);
    if (wr == 0) PG8_BAR;
    PG8_BAR;
    if constexpr (Epi::AFTER_DRAIN) { E.fused(acc, cur, wr, wc, fr, fq, lds, wid, lane); S.done(cur); }
    PG8_STAMP();
    if (STAMP && wid == 0) { stamps[lane] = lane < nts ? (((unsigned long long)(unsigned)ts_hi << 32) | (unsigned)ts_lo) : 0ull;
        if (lane == 62) stamps[62] = rt_entry; if (lane == 63) stamps[63] = (unsigned long long)wall_clock64(); }
#undef PG8_STAMP
#undef PG8_SA
#undef PG8_SB
#undef PG8_STAGE
#undef PG8_LDA
#undef PG8_LDB
#undef PG8_MMA
#undef PG8_WAIT_V
#undef PG8_WAIT_L
#undef PG8_BAR
#undef PG8_SCHED
}
}
#define LAS __attribute__((address_space(3)))
#define XB_TMO      128
#define XB_XCNT(j)  (256  + 64 * (j))
#define XB_XSUB(j)  (1280 + 64 * (j))
#define XB_XGEN(j)  (2304 + 64 * (j))
#define XB_TOP      3328
#define XB_TOPGEN   3392
#define XCD_BAR_WORDS 3456
#define XB_SPIN_CAP (1u << 18)


__device__ __forceinline__ unsigned xb_ld(unsigned* p)              { return __hip_atomic_load(p, __ATOMIC_RELAXED, __HIP_MEMORY_SCOPE_AGENT); }
__device__ __forceinline__ unsigned xb_add(unsigned* p, unsigned v) { return __hip_atomic_fetch_add(p, v, __ATOMIC_RELAXED, __HIP_MEMORY_SCOPE_AGENT); }
__device__ __forceinline__ unsigned xb_xcc_id() { return (unsigned)__builtin_amdgcn_s_getreg((3 << 11) | 20) & 0xFu; }
#define XB_SPIN(cond, bar) do { unsigned _sp = 0; while (cond) { __builtin_amdgcn_s_sleep(1); \
    if ((++_sp & 255u) == 0u) { if (xb_ld(&(bar)[XB_TMO])) break; if (_sp > XB_SPIN_CAP) { atomicAdd(&(bar)[XB_TMO], 1u); break; } } } } while (0)

struct XcdBarrier {
    unsigned* bar; unsigned x;
    volatile LAS unsigned* st;
};

__device__ __forceinline__ XcdBarrier xcd_barrier_post(unsigned* bar, volatile LAS unsigned* st) {
    XcdBarrier b; b.bar = bar; b.x = xb_xcc_id(); b.st = st;
    if (threadIdx.x == 0) (void)xb_add(&bar[XB_XCNT(b.x)], 1u);
    return b;
}
__device__ __forceinline__ void xcd_barrier_complete(unsigned* bar, unsigned x, unsigned& nloc, unsigned& nx) {
    const unsigned G = gridDim.x * gridDim.y * gridDim.z;
    unsigned sum, cnt, mine, sp = 0u;
    for (;;) {
        sum = 0u; cnt = 0u; mine = 0u;
#pragma unroll
        for (unsigned j = 0; j < 16; ++j) { const unsigned c = xb_ld(&bar[XB_XCNT(j)]); sum += c; cnt += (c > 0u) ? 1u : 0u; mine = (j == x) ? c : mine; }
        if (sum == G) break;
        __builtin_amdgcn_s_sleep(1);
        if ((++sp & 255u) == 0u) { if (xb_ld(&bar[XB_TMO])) break; if (sp > XB_SPIN_CAP) { atomicAdd(&bar[XB_TMO], 1u); break; } }
    }
    nloc = mine > 0u ? mine : 1u; nx = cnt > 0u ? cnt : 1u;
}

__device__ __forceinline__ void xcd_barrier(const XcdBarrier& b) {
    asm volatile("s_waitcnt vmcnt(0)" ::: "memory");
    __syncthreads();
    if (threadIdx.x == 0) {
        unsigned* bar = b.bar;
        __builtin_amdgcn_s_waitcnt(0);
        unsigned nloc = b.st[0], nx = b.st[1];
        if (nloc == 0u) { xcd_barrier_complete(bar, b.x, nloc, nx); b.st[0] = nloc; b.st[1] = nx; }
        const unsigned old = xb_add(&bar[XB_XSUB(b.x)], 1u);
        const unsigned gen = old / nloc;
        if (old + 1u == (gen + 1u) * nloc) {
            __builtin_amdgcn_fence(__ATOMIC_RELEASE, "agent");
            asm volatile("s_waitcnt vmcnt(0)" ::: "memory");
            const unsigned og = xb_add(&bar[XB_TOP], 1u);
            const unsigned tg = og / nx;
            if (og + 1u == (tg + 1u) * nx) xb_add(&bar[XB_TOPGEN], 1u);
            else XB_SPIN(xb_ld(&bar[XB_TOPGEN]) == tg, bar);
            __builtin_amdgcn_fence(__ATOMIC_ACQUIRE, "agent");
            xb_add(&bar[XB_XGEN(b.x)], 1u);
            asm volatile("s_waitcnt vmcnt(0)" ::: "memory");
        } else {
            XB_SPIN(xb_ld(&bar[XB_XGEN(b.x)]) == gen, bar);
            __builtin_amdgcn_fence(__ATOMIC_ACQUIRE, "agent");
            asm volatile("s_waitcnt vmcnt(0)" ::: "memory");
        }
    }
    __syncthreads();
}

using pg8::bf16_t; using pg8::bf16x8; using pg8::f32x4; using pg8::u32x4; using pg8::Unit; using pg8::BM; using pg8::HALF;
typedef float f32x2 __attribute__((ext_vector_type(2)));
typedef unsigned u32x2 __attribute__((ext_vector_type(2)));
typedef _Float16 f16x4 __attribute__((ext_vector_type(4)));

constexpr int D = 1024, FF = 2816, NIN = 1536, GWID = 512, DEPTH = 4;
constexpr int SEQ = 2048, NB = 8, MP = NB * SEQ, MS = 128, MV = MP + MS, MPAD = 16640;
constexpr int NTHR = 512, NWAVES = 8;
constexpr int LDS_STAGE = 131072, LDS_BYTES = LDS_STAGE + 16;
constexpr float LN_EPS = 1e-5f;
constexpr float ALPHA = 1.6817928305074292f;

constexpr size_t W_GU1 = 0, W_D1 = W_GU1 + (size_t)2 * FF * D, W_IN = W_D1 + (size_t)FF * D, W_OUT = W_IN + (size_t)NIN * D,
                 W_GU2 = W_OUT + (size_t)D * D, W_D2 = W_GU2 + (size_t)2 * FF * D, W_LAYER = W_D2 + (size_t)FF * D;
constexpr size_t WS_W = 0;
constexpr size_t WS_SMALL = WS_W + W_LAYER * 2 * DEPTH;
constexpr size_t SMALL_LAYER = 32768 * 2 + 65536;
constexpr size_t WS_X = WS_SMALL + SMALL_LAYER * 2 * DEPTH;
constexpr size_t WS_XN = WS_X + (size_t)MPAD * D * 4;
constexpr size_t WS_HP = WS_XN + (size_t)MPAD * D * 2;
constexpr size_t WS_MIX = WS_HP + (size_t)MPAD * NIN * 4;
constexpr size_t WS_AGG = WS_MIX + (size_t)MPAD * D * 2;
constexpr size_t WS_BAR = WS_AGG + (size_t)NB * 32 * 2 * 512 * 4;
constexpr size_t WS_PART = WS_BAR + 16384;
constexpr size_t WS_END = WS_PART + (size_t)4 * MS * D * 4;
static_assert((size_t)MPAD * FF * 2 <= (size_t)MPAD * NIN * 4, "hid fits in the proj region");
static_assert(WS_END <= 408000000ull, "workspace budget");

constexpr size_t O_Y = 0, O_PH = (size_t)MV * D, O_PC = O_PH + (size_t)DEPTH * NB * GWID, O_PP = O_PC + (size_t)DEPTH * NB * 3 * GWID,
                 O_SH = O_PP + (size_t)DEPTH * NB * 15 * GWID, O_SC = O_SH + (size_t)DEPTH * MS * GWID, O_SP = O_SC + (size_t)DEPTH * MS * 3 * GWID;

struct Params { const float* in[24]; float* out; unsigned char* ws; };
typedef const Params __attribute__((address_space(4))) CParams;
enum { I_XP = 0, I_XS, I_SH, I_SC, I_SP, I_LNG, I_LNB, I_W1G, I_W1U, I_W1D, I_WIN, I_CW, I_CB, I_GAW, I_GAB, I_GXW, I_GXB, I_LAM, I_PW, I_PS, I_WOUT, I_W2G, I_W2U, I_W2D };

__device__ __forceinline__ unsigned pk2(float lo, float hi) { return pg8::cvt_pk_bf16(lo, hi); }
__device__ __forceinline__ bf16_t f2bf(float f) { return (bf16_t)(pg8::cvt_pk_bf16(f, 0.f) & 0xffffu); }
__device__ __forceinline__ float wave_sum(float v) {
#pragma unroll
    for (int o = 1; o < 64; o <<= 1) v += __shfl_xor(v, o);
    return v;
}
__device__ __forceinline__ float sigmoidf_(float x) { return 1.0f / (1.0f + __expf(-x)); }
__device__ __forceinline__ float gelu_tanh(float x) {
    const float z = 0.7978845608028654f * (x + 0.044715f * x * x * x);
    const float e = __expf(2.0f * z);
    const float th = 1.0f - 2.0f / (e + 1.0f);
    return 0.5f * x * (1.0f + th);
}

struct EpiSwiglu {
    static constexpr bool PERM = true, AFTER_DRAIN = false;
    bf16_t* O; int ldc;
    __device__ __forceinline__ void operator()(const f32x4 (&acc)[2][2][4][2], const Unit& u, int wr, int wc, int fr, int fq) const {
        const int row0 = u.pm * BM + wr * 64 + fr, col0 = u.pn * 128 + wc * 32 + 8 * fq;
#pragma unroll
        for (int ai = 0; ai < 2; ++ai)
#pragma unroll
            for (int m = 0; m < 4; ++m) {
                bf16_t* rowp = O + (size_t)(row0 + ai * HALF + m * 16) * ldc + col0;
                float h[8];
#pragma unroll
                for (int n = 0; n < 2; ++n)
#pragma unroll
                    for (int j = 0; j < 4; ++j) { const float g = acc[ai][0][m][n][j], up = acc[ai][1][m][n][j]; h[n * 4 + j] = g * __builtin_amdgcn_rcpf(1.0f + __expf(-g)) * up; }
                u32x4 w; w.x = pk2(h[0], h[1]); w.y = pk2(h[2], h[3]); w.z = pk2(h[4], h[5]); w.w = pk2(h[6], h[7]);
                *(u32x4*)rowp = w;
            }
    }
};
struct EpiResid {
    static constexpr bool PERM = false, AFTER_DRAIN = false;
    float* X; int ldc; float alpha, coef;
    __device__ __forceinline__ void operator()(const f32x4 (&acc)[2][2][4][2], const Unit& u, int wr, int wc, int fr, int fq) const {
        const int row0 = u.pm * BM + wr * 64 + fr, col0 = u.pn * BM + wc * 32 + 4 * fq;
#pragma unroll
        for (int ai = 0; ai < 2; ++ai)
#pragma unroll
            for (int m = 0; m < 4; ++m) { float* rowp = X + (size_t)(row0 + ai * HALF + m * 16) * ldc + col0;
#pragma unroll
                for (int bj = 0; bj < 2; ++bj)
#pragma unroll
                    for (int n = 0; n < 2; ++n) { f32x4* p = (f32x4*)(rowp + bj * HALF + n * 16); const f32x4 v = *p; *p = v * alpha + acc[ai][bj][m][n] * coef; } }
    }
};

__device__ __forceinline__ void transpose_item(const float* W, int K, int N, bf16_t* WT, int mode, LAS float* scr, int item, int lane) {
    const int nblk = N / 32, kb = item / nblk, nb = item % nblk, k0 = 64 * kb, n0 = 32 * nb;
    const int drow0 = mode == 0 ? n0 : (256 * (n0 >> 7) + (n0 & 127) + (mode == 2 ? 128 : 0));
#pragma unroll 8
    for (int i = 0; i < 32; ++i) { const int kk = 2 * i + (lane >> 5); scr[kk * 33 + (lane & 31)] = W[(size_t)(k0 + kk) * N + n0 + (lane & 31)]; }
    asm volatile("s_waitcnt lgkmcnt(0)" ::: "memory");
    const int c = lane & 7;
#pragma unroll
    for (int j = 0; j < 4; ++j) { const int n = (lane >> 3) + 8 * j; const LAS float* s = scr + (8 * c) * 33 + n;
        u32x4 o; o.x = pk2(s[0 * 33], s[1 * 33]); o.y = pk2(s[2 * 33], s[3 * 33]); o.z = pk2(s[4 * 33], s[5 * 33]); o.w = pk2(s[6 * 33], s[7 * 33]);
        *(u32x4*)(WT + (size_t)(drow0 + n) * K + k0 + 8 * c) = o; }
    asm volatile("s_waitcnt lgkmcnt(0)" ::: "memory");
}
__device__ __forceinline__ void prologue(CParams* P, LAS unsigned char* lds, int gw, int NGW, int wave, int lane) {
    LAS float* scr = (LAS float*)(lds + wave * 16384);
    bf16_t* Wb = (bf16_t*)(P->ws + WS_W);
    constexpr int I_G = (D / 64) * (FF / 32), I_DN = (FF / 64) * (D / 32), I_I = (D / 64) * (NIN / 32), I_O = (D / 64) * (D / 32);
    constexpr int PER_LAYER = 4 * I_G + 2 * I_DN + I_I + I_O;
    for (int it = gw; it < PER_LAYER * DEPTH; it += NGW) {
        const int l = it / PER_LAYER; int r = it % PER_LAYER; bf16_t* WL = Wb + (size_t)l * W_LAYER;
        if (r < I_G) { transpose_item(P->in[I_W1G] + (size_t)l * D * FF, D, FF, WL + W_GU1, 1, scr, r, lane); continue; } r -= I_G;
        if (r < I_G) { transpose_item(P->in[I_W1U] + (size_t)l * D * FF, D, FF, WL + W_GU1, 2, scr, r, lane); continue; } r -= I_G;
        if (r < I_DN) { transpose_item(P->in[I_W1D] + (size_t)l * D * FF, FF, D, WL + W_D1, 0, scr, r, lane); continue; } r -= I_DN;
        if (r < I_I) { transpose_item(P->in[I_WIN] + (size_t)l * D * NIN, D, NIN, WL + W_IN, 0, scr, r, lane); continue; } r -= I_I;
        if (r < I_O) { transpose_item(P->in[I_WOUT] + (size_t)l * D * D, D, D, WL + W_OUT, 0, scr, r, lane); continue; } r -= I_O;
        if (r < I_G) { transpose_item(P->in[I_W2G] + (size_t)l * D * FF, D, FF, WL + W_GU2, 1, scr, r, lane); continue; } r -= I_G;
        if (r < I_G) { transpose_item(P->in[I_W2U] + (size_t)l * D * FF, D, FF, WL + W_GU2, 2, scr, r, lane); continue; } r -= I_G;
        transpose_item(P->in[I_W2D] + (size_t)l * D * FF, FF, D, WL + W_D2, 0, scr, r, lane);
    }
    bf16_t* Sm = (bf16_t*)(P->ws + WS_SMALL);
    const int gt = gw * 64 + lane, NGT = NGW * 64;
    for (int o = gt; o < DEPTH * 32768; o += NGT) {
        const int l = o / 32768, rem = o % 32768, h = rem / 4096, j = (rem / 64) % 64, i = rem % 64;
        const size_t src = (size_t)l * 32768 + h * 4096 + i * 64 + j;
        Sm[(size_t)l * SMALL_LAYER + rem] = f2bf(P->in[I_GAW][src]);
        Sm[(size_t)l * SMALL_LAYER + 32768 + rem] = f2bf(P->in[I_GXW][src]);
    }
    for (int o = gt; o < DEPTH * 65536; o += NGT) {
        const int l = o / 65536, rem = o % 65536, g = rem / 16384, j = (rem / 128) % 128, i = rem % 128;
        Sm[(size_t)l * SMALL_LAYER + 65536 + rem] = f2bf(P->in[I_PW][(size_t)l * 65536 + g * 16384 + i * 128 + j]);
    }
    for (int o = gt; o < DEPTH * MS * 2 * (GWID / 4); o += NGT) { const int c4 = o % (GWID / 4), k = (o / (GWID / 4)) % 2, lb = o / (2 * (GWID / 4));
        *(f32x4*)(P->out + O_SC + ((size_t)lb * 3 + k) * GWID + 4 * c4) = *(const f32x4*)(P->in[I_SC] + ((size_t)lb * 3 + k + 1) * GWID + 4 * c4); }
    for (int o = gt; o < DEPTH * MS * 14 * (GWID / 4); o += NGT) { const int c4 = o % (GWID / 4), k = (o / (GWID / 4)) % 14, lb = o / (14 * (GWID / 4));
        *(f32x4*)(P->out + O_SP + ((size_t)lb * 15 + k) * GWID + 4 * c4) = *(const f32x4*)(P->in[I_SP] + ((size_t)lb * 15 + k + 1) * GWID + 4 * c4); }
    float* X = (float*)(P->ws + WS_X); bf16_t* XN = (bf16_t*)(P->ws + WS_XN);
    for (int m = gw; m < MV; m += NGW) {
        const float* src = m < MP ? P->in[I_XP] + (size_t)m * D : P->in[I_XS] + (size_t)(m - MP) * D;
        const f32x4* xr = (const f32x4*)src + lane; f32x4* xo = (f32x4*)(X + (size_t)m * D) + lane; u32x2* o8 = (u32x2*)(XN + (size_t)m * D) + lane;
#pragma unroll
        for (int j = 0; j < 4; ++j) { const f32x4 v = xr[64 * j]; xo[64 * j] = v; u32x2 w; w.x = pk2(v[0], v[1]); w.y = pk2(v[2], v[3]); o8[64 * j] = w; }
    }
}

__device__ __forceinline__ void sample_skinny(const bf16_t* A  , const bf16_t* Bt  , int K, float* part, int bid, int wave, int fr, int fq) {
    if (bid >= 256) return;
    const int cb = bid & 63, ks = bid >> 6, Ks = K >> 2, n0 = 16 * cb;
    const bf16_t* ap = A + (size_t)(16 * wave + fr) * K + ks * Ks + 8 * fq;
    const bf16_t* bp = Bt + (size_t)(n0 + fr) * K + ks * Ks + 8 * fq;
    f32x4 acc = (f32x4){0.f, 0.f, 0.f, 0.f};
    const int nk = Ks >> 5;
    int kb = 0;
    for (; kb + 8 <= nk; kb += 8) {
        bf16x8 a[8], bb[8];
#pragma unroll
        for (int i = 0; i < 8; ++i) { a[i] = *(const bf16x8*)(ap + (kb + i) * 32); bb[i] = *(const bf16x8*)(bp + (kb + i) * 32); }
#pragma unroll
        for (int i = 0; i < 8; ++i) acc = __builtin_amdgcn_mfma_f32_16x16x32_bf16(bb[i], a[i], acc, 0, 0, 0);
    }
    for (; kb < nk; ++kb) { const bf16x8 a = *(const bf16x8*)(ap + kb * 32), bb = *(const bf16x8*)(bp + kb * 32); acc = __builtin_amdgcn_mfma_f32_16x16x32_bf16(bb, a, acc, 0, 0, 0); }
    *(f32x4*)(part + ((size_t)ks * MS + 16 * wave + fr) * D + n0 + 4 * fq) = acc;
}

__device__ __forceinline__ void ln_pass(float* X, bf16_t* XN, float* OUT, const float* g, const float* b, const float* part, float coef, int gw, int NGW, int lane) {
    f32x4 gg[4], bb[4];
#pragma unroll
    for (int j = 0; j < 4; ++j) { gg[j] = ((const f32x4*)g)[lane + 64 * j]; bb[j] = ((const f32x4*)b)[lane + 64 * j]; }
    for (int m = gw; m < MV; m += NGW) {
        const f32x4* xr = (const f32x4*)(X + (size_t)m * D) + lane;
        f32x4 v[4]; float s = 0.f;
#pragma unroll
        for (int j = 0; j < 4; ++j) v[j] = xr[64 * j];
        if (m >= MP) {
#pragma unroll
            for (int j = 0; j < 4; ++j) { f32x4 a = (f32x4){0.f, 0.f, 0.f, 0.f};
#pragma unroll
                for (int ks = 0; ks < 4; ++ks) a += ((const f32x4*)(part + ((size_t)ks * MS + (m - MP)) * D) + lane)[64 * j];
                v[j] = v[j] * ALPHA + a * coef; }
        }
#pragma unroll
        for (int j = 0; j < 4; ++j) s += (v[j][0] + v[j][1]) + (v[j][2] + v[j][3]);
        const float mean = wave_sum(s) * (1.f / D); float s2 = 0.f;
#pragma unroll
        for (int j = 0; j < 4; ++j) { v[j] = v[j] - mean; s2 += (v[j][0] * v[j][0] + v[j][1] * v[j][1]) + (v[j][2] * v[j][2] + v[j][3] * v[j][3]); }
        const float rstd = 1.0f / sqrtf(wave_sum(s2) * (1.f / D) + LN_EPS);
        f32x4* xo = (f32x4*)((OUT ? OUT : X) + (size_t)m * D) + lane; u32x2* o8 = (u32x2*)(XN + (size_t)m * D) + lane;
#pragma unroll
        for (int j = 0; j < 4; ++j) { const f32x4 y = v[j] * rstd * gg[j] + bb[j]; xo[64 * j] = y; u32x2 w; w.x = pk2(y[0], y[1]); w.y = pk2(y[2], y[3]); o8[64 * j] = w; }
    }
}

constexpr int XCS = 520;
constexpr int XC_OFF = 0, R_OFF = 32 * XCS * 2, I_OFF = 2 * 32 * XCS * 2;

__device__ __forceinline__ void gates_mfma(LAS unsigned char* lds, const bf16_t* WaT, const bf16_t* WxT, const float* ba, const float* bx, int h, int fr, int fq) {
    bf16x8 A[2][2];
#pragma unroll
    for (int mb = 0; mb < 2; ++mb)
#pragma unroll
        for (int kb = 0; kb < 2; ++kb) A[mb][kb] = *(const LAS bf16x8*)(lds + XC_OFF + ((mb * 16 + fr) * XCS + 64 * h + kb * 32 + 8 * fq) * 2);
#pragma unroll
    for (int gate = 0; gate < 2; ++gate) {
        const bf16_t* W = (gate ? WxT : WaT) + h * 4096; const float* bias = (gate ? bx : ba) + 64 * h; const int ooff = gate ? I_OFF : R_OFF;
#pragma unroll
        for (int nb = 0; nb < 4; ++nb) {
            const bf16x8 B0 = *(const bf16x8*)(W + (nb * 16 + fr) * 64 + 8 * fq), B1 = *(const bf16x8*)(W + (nb * 16 + fr) * 64 + 32 + 8 * fq);
            const f32x4 bv = *(const f32x4*)(bias + nb * 16 + 4 * fq);
#pragma unroll
            for (int mb = 0; mb < 2; ++mb) {
                f32x4 acc = (f32x4){0.f, 0.f, 0.f, 0.f};
                acc = __builtin_amdgcn_mfma_f32_16x16x32_bf16(B0, A[mb][0], acc, 0, 0, 0);
                acc = __builtin_amdgcn_mfma_f32_16x16x32_bf16(B1, A[mb][1], acc, 0, 0, 0);
                acc = acc + bv;
                f16x4 hv; hv[0] = (_Float16)sigmoidf_(acc[0]); hv[1] = (_Float16)sigmoidf_(acc[1]); hv[2] = (_Float16)sigmoidf_(acc[2]); hv[3] = (_Float16)sigmoidf_(acc[3]);
                *(LAS f16x4*)(lds + ooff + ((mb * 16 + fr) * XCS + 64 * h + nb * 16 + 4 * fq) * 2) = hv;
            }
        }
    }
}
template <int NMB>
__device__ __forceinline__ void pool_mfma(LAS unsigned char* lds, const bf16_t* PWT, const float* pscale, bf16_t* mixrow, int w, int fr, int fq) {
    const int g = w >> 1, half = w & 1;
    f32x4 acc[NMB][4];
#pragma unroll
    for (int mb = 0; mb < NMB; ++mb)
#pragma unroll
        for (int nb = 0; nb < 4; ++nb) acc[mb][nb] = (f32x4){0.f, 0.f, 0.f, 0.f};
#pragma unroll
    for (int kb = 0; kb < 4; ++kb) {
        bf16x8 A[NMB];
#pragma unroll
        for (int mb = 0; mb < NMB; ++mb) A[mb] = *(const LAS bf16x8*)(lds + ((mb * 16 + fr) * XCS + 128 * g + kb * 32 + 8 * fq) * 2);
#pragma unroll
        for (int nb = 0; nb < 4; ++nb) {
            const bf16x8 B = *(const bf16x8*)(PWT + ((size_t)g * 128 + 64 * half + nb * 16 + fr) * 128 + kb * 32 + 8 * fq);
#pragma unroll
            for (int mb = 0; mb < NMB; ++mb) acc[mb][nb] = __builtin_amdgcn_mfma_f32_16x16x32_bf16(B, A[mb], acc[mb][nb], 0, 0, 0);
        }
    }
#pragma unroll
    for (int nb = 0; nb < 4; ++nb) {
        const int ch = 128 * g + 64 * half + nb * 16 + 4 * fq; const f32x4 sc = *(const f32x4*)(pscale + ch);
#pragma unroll
        for (int mb = 0; mb < NMB; ++mb) { const f32x4 v = acc[mb][nb] * sc; u32x2 o; o.x = pk2(v[0], v[1]); o.y = pk2(v[2], v[3]);
            *(u32x2*)(mixrow + (size_t)(mb * 16 + fr) * D + GWID + ch) = o; }
    }
}
template <int W>
__device__ __forceinline__ void pool_prompt_thread(const float* UP, int t0, LAS bf16_t* PL, int c) {
    float hist[W - 1], v[64]; float s = 0.f;
#pragma unroll
    for (int k = 0; k < W - 1; ++k) hist[k] = (t0 > 0) ? (UP + (k - (W - 1)) * NIN)[c] : 0.f;
#pragma unroll
    for (int t = 0; t < 64; ++t) v[t] = (UP + t * NIN)[c];
#pragma unroll
    for (int k = 0; k < W - 1; ++k) s += hist[k];
#pragma unroll
    for (int t = 0; t < 64; ++t) {
        s += v[t];
        const float rc = (t >= W - 1 || t0 > 0) ? (1.0f / (float)W) : (1.0f / (float)(t + 1));
        PL[t * XCS + c] = f2bf(s * rc - v[t]);
        s -= (t - W + 1 >= 0) ? v[t - W + 1 >= 0 ? t - W + 1 : 0] : hist[t < W - 1 ? t : 0];
    }
}
template <int W>
__device__ __forceinline__ void pool_sample_thread(const float* UP, const float* SPs, float* SPo, LAS bf16_t* PL, int c) {
    float v[32];
#pragma unroll
    for (int t = 0; t < 32; ++t) v[t] = (UP + (size_t)t * NIN)[c];
#pragma unroll
    for (int t0 = 0; t0 < 32; t0 += 4) {
        float q[4][W - 1];
#pragma unroll
        for (int t = 0; t < 4; ++t)
#pragma unroll
            for (int k = 0; k < W - 1; ++k) q[t][k] = (SPs + ((size_t)(t0 + t) * 15 + (16 - W) + k) * GWID)[c];
#pragma unroll
        for (int t = 0; t < 4; ++t) { float s = v[t0 + t];
#pragma unroll
            for (int k = 0; k < W - 1; ++k) s += q[t][k];
            PL[(t0 + t) * XCS + c] = f2bf(s * (1.0f / (float)W) - v[t0 + t]); }
    }
#pragma unroll
    for (int t = 0; t < 32; ++t) (SPo + ((size_t)t * 15 + 14) * GWID)[c] = v[t];
}

struct MixW {
    const float *cw, *cb, *gab, *gxb, *lam, *psc; const bf16_t *GAT, *GXT, *PWT;
};

__global__ void __launch_bounds__(NTHR, 2) fwd_megakernel(Params p) {
    extern __shared__ __attribute__((aligned(16))) unsigned char lds_raw[];
    LAS unsigned char* lds = (LAS unsigned char*)lds_raw;
    cg::grid_group grid = cg::this_grid();
    const int G0 = gridDim.x, bid0 = blockIdx.x;

#ifdef TIME_CLASS
    const unsigned long long t_pro0 = __builtin_amdgcn_s_memrealtime();
#endif
    if (threadIdx.x == 0) { ((LAS unsigned*)(lds + LDS_STAGE))[0] = 0u; ((LAS unsigned*)(lds + LDS_STAGE))[1] = 0u; }
    __syncthreads();
    (void)xcd_barrier_post((unsigned*)(((CParams*)__builtin_amdgcn_kernarg_segment_ptr())->ws + WS_BAR), (volatile LAS unsigned*)(lds + LDS_STAGE));
#define GSYNC() do { XcdBarrier b_; b_.bar = (unsigned*)(ws + WS_BAR); b_.x = xb_xcc_id(); b_.st = (volatile LAS unsigned*)(lds + LDS_STAGE); xcd_barrier(b_); } while (0)
    { const int tid = threadIdx.x, lane = tid & 63, wave = __builtin_amdgcn_readfirstlane(tid >> 6);
      prologue((CParams*)__builtin_amdgcn_kernarg_segment_ptr(), lds, bid0 * NWAVES + wave, G0 * NWAVES, wave, lane); }
    grid.sync();

    constexpr int NK = 10;
#ifdef TIME_CLASS
    unsigned long long t_acc = (TIME_CLASS == 5) ? (__builtin_amdgcn_s_memrealtime() - t_pro0) : 0ull;
#endif
    for (int ph = 0; ph < DEPTH * NK; ++ph) {
        const int l = ph / NK, kind = ph % NK;
#ifdef TIME_CLASS
        const unsigned long long t_beg = __builtin_amdgcn_s_memrealtime();
#endif
        int G = G0, bid = bid0; asm volatile("" : "+s"(G), "+s"(bid));
        const int NGW = G * NWAVES;
        int tid = threadIdx.x; asm volatile("" : "+v"(tid));
        const int lane = tid & 63, wave = __builtin_amdgcn_readfirstlane(tid >> 6), fr = lane & 15, fq = lane >> 4, gw = bid * NWAVES + wave;
        CParams* P = (CParams*)__builtin_amdgcn_kernarg_segment_ptr(); asm volatile("" : "+s"(P));
        unsigned char* const ws = P->ws;
        float* X = (float*)(ws + WS_X); bf16_t* XN = (bf16_t*)(ws + WS_XN); bf16_t* HID = (bf16_t*)(ws + WS_HP); float* PROJ = (float*)(ws + WS_HP);
        bf16_t* MIX = (bf16_t*)(ws + WS_MIX); float* AGG = (float*)(ws + WS_AGG);
        const bf16_t* Wb = (const bf16_t*)(ws + WS_W); const bf16_t* Sm = (const bf16_t*)(ws + WS_SMALL);
        const bf16_t* WL = Wb + (size_t)l * W_LAYER;
        if (kind == 0 || kind == 7) {
            pg8::Gemm g{XN, WL + (kind == 0 ? W_GU1 : W_GU2), MPAD, 2 * FF, D}; pg8::StaticOrder S; S.init(MPAD, 2 * FF, G, bid);
            EpiSwiglu E{HID, FF};
            pg8::gemm_phase<EpiSwiglu, pg8::StaticOrder>(lds, g, S, E, nullptr);
        } else if (kind == 1 || kind == 8 || kind == 5) {
            const bool wo = (kind == 5);
            const bf16_t* Bw = WL + (wo ? W_OUT : (kind == 1 ? W_D1 : W_D2)); const int Kd = wo ? D : FF;
            sample_skinny((wo ? MIX : HID) + (size_t)MP * Kd, Bw, Kd, (float*)(ws + WS_PART), bid, wave, fr, fq);
            pg8::Gemm g{wo ? MIX : HID, Bw, MP, D, Kd}; pg8::StaticOrder S; S.init(MP, D, G, bid);
            EpiResid E{X, D, ALPHA, wo ? 1.0f : 0.5f};
            pg8::gemm_phase<EpiResid, pg8::StaticOrder>(lds, g, S, E, nullptr);
        } else if (kind == 3) {
            pg8::Gemm g{XN, WL + W_IN, MPAD, NIN, D}; pg8::StaticOrder S; S.init(MPAD, NIN, G, bid);
            pg8::EpiF32 E{PROJ, NIN, nullptr};
            pg8::gemm_phase<pg8::EpiF32, pg8::StaticOrder>(lds, g, S, E, nullptr);
        } else if (kind == 2 || kind == 6 || kind == 9) {
            const int which = kind == 2 ? 0 : (kind == 6 ? 1 : 2);
            const bool fin = (l == DEPTH - 1 && which == 2);
            ln_pass(X, XN, fin ? P->out + O_Y : nullptr, P->in[I_LNG] + (size_t)(l * 3 + which) * D, P->in[I_LNB] + (size_t)(l * 3 + which) * D, (const float*)(ws + WS_PART), which == 1 ? 1.0f : 0.5f, gw, NGW, lane);
        } else {
            MixW mw; mw.cw = P->in[I_CW] + (size_t)l * 4 * GWID; mw.cb = P->in[I_CB] + (size_t)l * GWID; mw.gab = P->in[I_GAB] + (size_t)l * GWID; mw.gxb = P->in[I_GXB] + (size_t)l * GWID;
            mw.lam = P->in[I_LAM] + (size_t)l * GWID; mw.psc = P->in[I_PS] + (size_t)l * GWID;
            mw.GAT = Sm + (size_t)l * SMALL_LAYER; mw.GXT = mw.GAT + 32768; mw.PWT = mw.GAT + 65536;
            const int c = tid;
            const bool has = bid < NB * 32;
            const int b = bid >> 5, j = bid & 31, t0 = j * 64; const size_t row0 = (size_t)b * SEQ + t0;
            const float cw0 = mw.cw[c], cw1 = mw.cw[GWID + c], cw2 = mw.cw[2 * GWID + c], cw3 = mw.cw[3 * GWID + c], cbv = mw.cb[c];
            const float lamv = mw.lam[c]; const float k8 = -8.0f * log1pf(__expf(-lamv));
            if (has) {
                const float* UP = PROJ + row0 * NIN + 2 * GWID; LAS bf16_t* PL = (LAS bf16_t*)lds;
                const int grp = wave >> 1;
                if (grp == 0) pool_prompt_thread<2>(UP, t0, PL, c); else if (grp == 1) pool_prompt_thread<4>(UP, t0, PL, c);
                else if (grp == 2) pool_prompt_thread<8>(UP, t0, PL, c); else pool_prompt_thread<16>(UP, t0, PL, c);
                if (j == 31) { float* o = P->out + O_PP + ((size_t)(l * NB + b) * 15) * GWID; float q[15];
#pragma unroll
                    for (int k = 0; k < 15; ++k) q[k] = (UP + (49 + k) * NIN)[c];
#pragma unroll
                    for (int k = 0; k < 15; ++k) (o + k * GWID)[c] = q[k]; }
                __syncthreads();
                pool_mfma<4>(lds, mw.PWT, mw.psc, MIX + row0 * D, wave, fr, fq);
                __syncthreads();
            }
            for (int pass = 0; pass < 2; ++pass) {
                if (has) {
                    float h = 0.f, cum = 1.f;
                    if (pass == 1) {
#pragma unroll 8
                        for (int i = 0; i < j; ++i) { const float A_ = (AGG + ((size_t)(b * 32 + i) * 2 + 0) * GWID)[c], H_ = (AGG + ((size_t)(b * 32 + i) * 2 + 1) * GWID)[c]; h = A_ * h + H_; }
                    }
                    const float* U = PROJ + row0 * NIN; bf16_t* mo = MIX + row0 * D;
                    float p0 = 0.f, p1 = 0.f, p2 = 0.f;
                    if (j > 0) { p0 = (U - 3 * NIN)[c]; p1 = (U - 2 * NIN)[c]; p2 = (U - 1 * NIN)[c]; }
                    for (int s = 0; s < 2; ++s) {
                        float xc[32], gt[32];
                        { float u[32];
#pragma unroll
                          for (int t = 0; t < 32; ++t) u[t] = (U + (s * 32 + t) * NIN)[c];
#pragma unroll
                          for (int t = 0; t < 32; ++t) gt[t] = (pass == 1) ? (U + (s * 32 + t) * NIN + GWID)[c] : 0.f;
#pragma unroll
                          for (int t = 0; t < 32; ++t) { const float v = u[t]; xc[t] = cbv + cw0 * p0 + cw1 * p1 + cw2 * p2 + cw3 * v; p0 = p1; p1 = p2; p2 = v;
                              ((LAS bf16_t*)(lds + XC_OFF))[t * XCS + c] = f2bf(xc[t]); } }
                        __syncthreads();
                        gates_mfma(lds, mw.GAT, mw.GXT, mw.gab, mw.gxb, wave, fr, fq);
                        __syncthreads();
#pragma unroll
                        for (int t = 0; t < 32; ++t) {
                            const float r = (float)((const LAS _Float16*)(lds + R_OFF))[t * XCS + c], ig = (float)((const LAS _Float16*)(lds + I_OFF))[t * XCS + c];
                            const float la = r * k8, a = __expf(la), mult = sqrtf(-expm1f(2.0f * la)), uu = mult * (ig * xc[t]);
                            h = a * h + uu; cum *= a;
                            if (pass == 1) (mo + (size_t)(s * 32 + t) * D)[c] = f2bf(h * gelu_tanh(gt[t]));
                        }
                        __syncthreads();
                    }
                    if (pass == 0) {
                        (AGG + ((size_t)(b * 32 + j) * 2 + 0) * GWID)[c] = cum; (AGG + ((size_t)(b * 32 + j) * 2 + 1) * GWID)[c] = h;
                        if (j == 31) { float* o = P->out + O_PC + ((size_t)(l * NB + b) * 3) * GWID; o[c] = p0; (o + GWID)[c] = p1; (o + 2 * GWID)[c] = p2; }
                    } else if (j == 31) (P->out + O_PH + (size_t)(l * NB + b) * GWID)[c] = h;
                }
                if (pass == 0) GSYNC();
            }
            if (bid >= G - 4) {
                const int b0 = (bid - (G - 4)) * 32; const size_t srow0 = (size_t)MP + b0;
                __syncthreads();
                {
                    const float* UP = PROJ + srow0 * NIN + 2 * GWID; LAS bf16_t* PL = (LAS bf16_t*)lds;
                    const float* SPs = P->in[I_SP] + ((size_t)(l * MS + b0) * 15) * GWID; float* SPo = P->out + O_SP + ((size_t)(l * MS + b0) * 15) * GWID;
                    const int grp = wave >> 1;
                    if (grp == 0) pool_sample_thread<2>(UP, SPs, SPo, PL, c); else if (grp == 1) pool_sample_thread<4>(UP, SPs, SPo, PL, c);
                    else if (grp == 2) pool_sample_thread<8>(UP, SPs, SPo, PL, c); else pool_sample_thread<16>(UP, SPs, SPo, PL, c);
                    __syncthreads();
                    pool_mfma<2>(lds, mw.PWT, mw.psc, MIX + srow0 * D, wave, fr, fq);
                    __syncthreads();
                }
                {
                    float xc[32], h0[32], gt[32];
                    { float u[32];
#pragma unroll
                      for (int t = 0; t < 32; ++t) u[t] = (PROJ + (srow0 + t) * NIN)[c];
#pragma unroll
                      for (int t = 0; t < 32; ++t) xc[t] = cbv;
#pragma unroll
                      for (int k = 0; k < 3; ++k) { float sk[32]; const float wk = k == 0 ? cw0 : (k == 1 ? cw1 : cw2);
#pragma unroll
                          for (int t = 0; t < 32; ++t) sk[t] = (P->in[I_SC] + ((size_t)(l * MS + b0 + t) * 3 + k) * GWID)[c];
#pragma unroll
                          for (int t = 0; t < 32; ++t) xc[t] += wk * sk[t]; }
#pragma unroll
                      for (int t = 0; t < 32; ++t) { xc[t] += cw3 * u[t]; ((LAS bf16_t*)(lds + XC_OFF))[t * XCS + c] = f2bf(xc[t]); }
#pragma unroll
                      for (int t = 0; t < 32; ++t) (P->out + O_SC + ((size_t)(l * MS + b0 + t) * 3 + 2) * GWID)[c] = u[t]; }
#pragma unroll
                    for (int t = 0; t < 32; ++t) { h0[t] = (P->in[I_SH] + (size_t)(l * MS + b0 + t) * GWID)[c]; gt[t] = (PROJ + (srow0 + t) * NIN + GWID)[c]; }
                    __syncthreads();
                    gates_mfma(lds, mw.GAT, mw.GXT, mw.gab, mw.gxb, wave, fr, fq);
                    __syncthreads();
#pragma unroll
                    for (int t = 0; t < 32; ++t) {
                        const float r = (float)((const LAS _Float16*)(lds + R_OFF))[t * XCS + c], ig = (float)((const LAS _Float16*)(lds + I_OFF))[t * XCS + c];
                        const float la = r * k8, a = __expf(la), mult = sqrtf(-expm1f(2.0f * la)), uu = mult * (ig * xc[t]);
                        const float hh = a * h0[t] + uu;
                        (P->out + O_SH + (size_t)(l * MS + b0 + t) * GWID)[c] = hh;
                        (MIX + (srow0 + t) * D)[c] = f2bf(hh * gelu_tanh(gt[t]));
                    }
                    __syncthreads();
                }
            }
        }
        if (ph != DEPTH * NK - 1) GSYNC();
#ifdef TIME_CLASS
        { const int cls = (kind == 0 || kind == 7) ? 0 : (kind == 1 || kind == 8) ? 1 : (kind == 3 || kind == 5) ? 2 : (kind == 4) ? 4 : 3;
          if (cls == TIME_CLASS) t_acc += __builtin_amdgcn_s_memrealtime() - t_beg; }
#endif
    }
#ifdef TIME_CLASS
    if (blockIdx.x == 0) { const unsigned long long t0 = __builtin_amdgcn_s_memrealtime(); while (__builtin_amdgcn_s_memrealtime() - t0 < t_acc) __builtin_amdgcn_s_sleep(8); }
#endif
}

extern "C" void kernel_launch(void* const* d_in, const int* in_sizes, int n_in, void* d_out, int out_size, void* d_ws, size_t ws_size, hipStream_t stream) {
    static int grid_blocks = 0;
    if (!grid_blocks) {
        int dev = 0, cus = 0, per_cu = 0;
        hipGetDevice(&dev);
        hipDeviceGetAttribute(&cus, hipDeviceAttributeMultiprocessorCount, dev);
        hipFuncSetAttribute((const void*)fwd_megakernel, hipFuncAttributeMaxDynamicSharedMemorySize, LDS_BYTES);
        hipOccupancyMaxActiveBlocksPerMultiprocessor(&per_cu, (const void*)fwd_megakernel, NTHR, LDS_BYTES);
        if (per_cu < 1) per_cu = 1;
        grid_blocks = cus * per_cu;
        if (grid_blocks > 256) grid_blocks = 256;
        if (ws_size < WS_END) fprintf(stderr, "kernel_launch: workspace too small: %zu < %zu\n", ws_size, (size_t)WS_END);
    }
    Params p{};
    for (int i = 0; i < 24; ++i) p.in[i] = (const float*)d_in[i];
    p.out = (float*)d_out; p.ws = (unsigned char*)d_ws;
    (void)hipMemsetAsync((unsigned char*)d_ws + WS_BAR, 0, 16384, stream);
    void* args[] = {&p};
    hipError_t e = hipLaunchCooperativeKernel((const void*)fwd_megakernel, dim3(grid_blocks), dim3(NTHR), args, LDS_BYTES, stream);
    if (e != hipSuccess) fprintf(stderr, "cooperative launch failed: %s (grid %d)\n", hipGetErrorString(e), grid_blocks);
}
```

```cpp
#include <hip/hip_runtime.h>
#include <hip/hip_cooperative_groups.h>
#include <cstdio>
namespace cg = cooperative_groups;
namespace pg8 {
#define PG8_LAS __attribute__((address_space(3)))
typedef unsigned short bf16_t;
typedef short bf16x8 __attribute__((ext_vector_type(8)));
typedef float f32x4 __attribute__((ext_vector_type(4)));
typedef unsigned u32x4 __attribute__((ext_vector_type(4)));
constexpr int BM = 256, BK = 64, HALF = 128, HTB = HALF * BK * 2  , STAGE_BYTES = 8 * HTB, NXCD = 8, WGM = 8;

__host__ __device__ __forceinline__ int lds_byte(int r, int c) { const int st = (r >> 4) * 2 + (c >> 5), rr = r & 15, cc = c & 31, ob = rr * 64 + cc * 2; return st * 1024 + (ob ^ (((ob >> 9) & 1) << 5)); }
__host__ __device__ __forceinline__ void stage_rc(int b, int& R, int& C) { const int st = b / 1024, sb = b % 1024, swz = sb ^ (((sb >> 9) & 1) << 5); R = (st >> 1) * 16 + swz / 64; C = (st & 1) * 32 + (swz % 64) / 2; }
__host__ __device__ __forceinline__ int perm32(int rho) { const int n = rho >> 4, i = rho & 15; return 8 * (i >> 2) + 4 * n + (i & 3); }

struct Unit { int pm, pn; };
struct Gemm { const bf16_t* A; const bf16_t* Bt; int M, N, K; };

struct StaticOrder {
    int nM, nN, nwg, G, c;
    __host__ __device__ void init(int M, int N, int G_, int c_) { nM = M / BM; nN = N / BM; nwg = nM * nN; G = G_; c = c_; }
    __host__ __device__ bool next(int i, Unit& u) const {
        const long L = (long)i * G + c; if (L >= nwg) return false;
        int wgid = (int)L; { const int q = nwg / NXCD, r = nwg % NXCD, xcd = wgid % NXCD, off = wgid / NXCD; wgid = (xcd < r ? xcd * (q + 1) : r * (q + 1) + (xcd - r) * q) + off; }
        const int nig = WGM * nN, gid = wgid / nig, fm = gid * WGM, gsz = (nM - fm) < WGM ? (nM - fm) : WGM;
        u.pm = fm + ((wgid % nig) % gsz); u.pn = (wgid % nig) / gsz; return true;
    }
    __device__ __forceinline__ void a_ready(const Unit&) const {}
    __device__ __forceinline__ void done(const Unit&) const {}
};
__device__ __forceinline__ unsigned cvt_pk_bf16(float lo, float hi) { unsigned r; asm volatile("v_cvt_pk_bf16_f32 %0, %1, %2" : "=v"(r) : "v"(lo), "v"(hi)); return r; }
typedef float f32x2 __attribute__((ext_vector_type(2)));
struct EpiF32 {
    static constexpr bool PERM = false, AFTER_DRAIN = false;
    float* C; int ldc; const float* bias;
    __device__ __forceinline__ void operator()(const f32x4 (&acc)[2][2][4][2], const Unit& u, int wr, int wc, int fr, int fq) const {
        const int row0 = u.pm * BM + wr * 64 + fr, col0 = u.pn * BM + wc * 32 + 4 * fq;
        f32x4 bv[2][2];
#pragma unroll
        for (int bj = 0; bj < 2; ++bj)
#pragma unroll
            for (int n = 0; n < 2; ++n) bv[bj][n] = bias ? *(const f32x4*)(bias + col0 + bj * HALF + n * 16) : (f32x4){0.f, 0.f, 0.f, 0.f};
#pragma unroll
        for (int ai = 0; ai < 2; ++ai)
#pragma unroll
            for (int m = 0; m < 4; ++m) { float* rowp = C + (size_t)(row0 + ai * HALF + m * 16) * ldc + col0;
#pragma unroll
                for (int bj = 0; bj < 2; ++bj)
#pragma unroll
                    for (int n = 0; n < 2; ++n) *(f32x4*)(rowp + bj * HALF + n * 16) = acc[ai][bj][m][n] + bv[bj][n]; }
    }
};
template <class Epi, class Sched, bool STAMP = false>
__device__ __forceinline__ void gemm_phase(PG8_LAS unsigned char* lds, const Gemm g, const Sched& S, const Epi& E, unsigned long long* stamps) {
    int tid_l = threadIdx.x; asm volatile("" : "+v"(tid_l));
    const int tid = tid_l, wid = __builtin_amdgcn_readfirstlane(tid >> 6), lane = tid & 63, wr = wid >> 2, wc = wid & 3, fr = lane & 15, fq = lane >> 4;
    const int K = g.K, nt = K / BK;
    int ts_lo = 0, ts_hi = 0, nts = 0; const unsigned long long rt_entry = STAMP ? (unsigned long long)wall_clock64() : 0ull;
#define PG8_STAMP() do { if (STAMP && wid == 0 && nts < 64) { const unsigned long long _c = (unsigned long long)clock64(); \
        ts_lo = (lane == nts) ? (int)(unsigned)_c : ts_lo; ts_hi = (lane == nts) ? (int)(unsigned)(_c >> 32) : ts_hi; ++nts; } } while (0)
    PG8_STAMP();
    unsigned voffA[2], voffB[2];
#pragma unroll
    for (int i = 0; i < 2; ++i) { int R, C; stage_rc(tid * 16 + i * 8192, R, C); const int Rb = Epi::PERM ? ((R & ~31) + perm32(R & 31)) : R;
        voffA[i] = (unsigned)(R * K + C) * 2u; voffB[i] = (unsigned)(Rb * K + C) * 2u; }
    const size_t kstep = (size_t)(BK * 2);
    const size_t hstep = (size_t)HALF * K * 2;
    const size_t tstep = 2 * hstep;
    const unsigned ldsw = (unsigned)wid * 1024u;
    const int aoff = lds_byte(wr * 64 + fr, fq * 8), boff = lds_byte(wc * 32 + fr, fq * 8);
#define PG8_SA(b, h) (((b) * 2 + (h)) * HTB)
#define PG8_SB(b, h) ((4 + (b) * 2 + (h)) * HTB)
#define PG8_STAGE(bufoff, gbase, voff) do { _Pragma("unroll") for (int _i = 0; _i < 2; ++_i) \
        __builtin_amdgcn_global_load_lds((const unsigned*)((const char*)(gbase) + (voff)[_i]), (PG8_LAS unsigned*)(lds + (bufoff) + ldsw + _i * 8192), 16, 0, 0); } while (0)
#define PG8_LDA(dst, b, h) do { _Pragma("unroll") for (int m = 0; m < 4; ++m) _Pragma("unroll") for (int k = 0; k < 2; ++k) dst[m][k] = *(const PG8_LAS bf16x8*)(lds + PG8_SA(b, h) + aoff + m * 2048 + k * 1024); } while (0)
#define PG8_LDB(dst, b, h) do { _Pragma("unroll") for (int n = 0; n < 2; ++n) _Pragma("unroll") for (int k = 0; k < 2; ++k) dst[n][k] = *(const PG8_LAS bf16x8*)(lds + PG8_SB(b, h) + boff + n * 2048 + k * 1024); } while (0)
#define PG8_MMA(ai, bj, At, Bt) do { __builtin_amdgcn_s_setprio(1); _Pragma("unroll") for (int m = 0; m < 4; ++m) _Pragma("unroll") for (int n = 0; n < 2; ++n) _Pragma("unroll") for (int k = 0; k < 2; ++k) \
        acc[ai][bj][m][n] = __builtin_amdgcn_mfma_f32_16x16x32_bf16(Bt[n][k], At[m][k], acc[ai][bj][m][n], 0, 0, 0); __builtin_amdgcn_s_setprio(0); } while (0)
#define PG8_WAIT_V(n) asm volatile("s_waitcnt vmcnt(" #n ")" ::: "memory")
#define PG8_WAIT_L(n) asm volatile("s_waitcnt lgkmcnt(" #n ")" ::: "memory")
#define PG8_BAR __builtin_amdgcn_s_barrier()
#define PG8_SCHED __builtin_amdgcn_sched_barrier(0)
    Unit cur, nxt; int ui = 0;
    if (!S.next(0, cur)) return;
    f32x4 acc[2][2][4][2];
#pragma unroll
    for (int a = 0; a < 2; ++a)
#pragma unroll
        for (int b = 0; b < 2; ++b)
#pragma unroll
            for (int m = 0; m < 4; ++m)
#pragma unroll
                for (int n = 0; n < 2; ++n) acc[a][b][m][n] = (f32x4){0.f, 0.f, 0.f, 0.f};
    bf16x8 At[4][2], B0[2][2], B1[2][2];
    const char* cA = (const char*)g.A + (size_t)cur.pm * tstep; const char* cB = (const char*)g.Bt + (size_t)cur.pn * tstep;
    S.a_ready(cur);
    PG8_STAGE(PG8_SB(0, 0), cB, voffB); PG8_STAGE(PG8_SA(0, 0), cA, voffA); PG8_STAGE(PG8_SB(0, 1), cB + hstep, voffB); PG8_STAGE(PG8_SA(0, 1), cA + hstep, voffA);
    if (wr == 1) PG8_BAR;
    PG8_WAIT_V(4); PG8_BAR;
    PG8_STAGE(PG8_SB(1, 0), cB + kstep, voffB); PG8_STAGE(PG8_SA(1, 0), cA + kstep, voffA); PG8_STAGE(PG8_SB(1, 1), cB + hstep + kstep, voffB);
    PG8_WAIT_V(6); PG8_BAR;
    PG8_STAMP();
    for (;;) {
        const bool has_next = S.next(ui + 1, nxt);
        const char* nA = has_next ? (const char*)g.A + (size_t)nxt.pm * tstep : cA; const char* nB = has_next ? (const char*)g.Bt + (size_t)nxt.pn * tstep : cB;
        for (int t = 0; t < nt; t += 2) {
            const bool last = (t == nt - 2);
            const char* a1 = cA + (size_t)(t + 1) * kstep;
            const char* a2 = last ? nA : cA + (size_t)(t + 2) * kstep; const char* b2 = last ? nB : cB + (size_t)(t + 2) * kstep;
            const char* a3 = a2 + kstep; const char* b3 = b2 + kstep;
            if (last && has_next) S.a_ready(nxt);
            PG8_LDB(B0, 0, 0); PG8_SCHED; PG8_LDA(At, 0, 0); PG8_STAGE(PG8_SA(1, 1), a1 + hstep, voffA);
            PG8_WAIT_L(8); PG8_BAR; PG8_WAIT_L(0); PG8_MMA(0, 0, At, B0); PG8_BAR; PG8_SCHED;
            PG8_LDB(B1, 0, 1); PG8_STAGE(PG8_SB(0, 0), b2, voffB);
            PG8_BAR; PG8_WAIT_L(0); PG8_MMA(0, 1, At, B1); PG8_BAR;
            PG8_LDA(At, 0, 1); PG8_STAGE(PG8_SA(0, 0), a2, voffA);
            PG8_BAR; PG8_WAIT_L(0); PG8_MMA(1, 0, At, B0); PG8_BAR; PG8_SCHED;
            PG8_STAGE(PG8_SB(0, 1), b2 + hstep, voffB);
            PG8_WAIT_V(6); PG8_BAR; PG8_MMA(1, 1, At, B1); PG8_BAR;
            PG8_LDB(B0, 1, 0); PG8_SCHED; PG8_LDA(At, 1, 0); PG8_STAGE(PG8_SA(0, 1), a2 + hstep, voffA);
            PG8_WAIT_L(8); PG8_BAR; PG8_WAIT_L(0); PG8_MMA(0, 0, At, B0); PG8_BAR; PG8_SCHED;
            PG8_LDB(B1, 1, 1); PG8_STAGE(PG8_SB(1, 0), b3, voffB);
            PG8_BAR; PG8_WAIT_L(0); PG8_MMA(0, 1, At, B1); PG8_BAR;
            PG8_LDA(At, 1, 1); PG8_STAGE(PG8_SA(1, 0), a3, voffA);
            PG8_BAR; PG8_WAIT_L(0); PG8_MMA(1, 0, At, B0); PG8_BAR; PG8_SCHED;
            PG8_STAGE(PG8_SB(1, 1), b3 + hstep, voffB);
            PG8_WAIT_V(6); PG8_BAR; PG8_MMA(1, 1, At, B1); PG8_BAR;
        }
        PG8_STAMP();
        if constexpr (!Epi::AFTER_DRAIN) { E(acc, cur, wr, wc, fr, fq); S.done(cur); }
        PG8_STAMP();
        if (!has_next) break;
#pragma unroll
        for (int a = 0; a < 2; ++a)
#pragma unroll
            for (int b = 0; b < 2; ++b)
#pragma unroll
                for (int m = 0; m < 4; ++m)
#pragma unroll
                    for (int n = 0; n < 2; ++n) acc[a][b][m][n] = (f32x4){0.f, 0.f, 0.f, 0.f};
        cur = nxt; cA = nA; cB = nB; ++ui;
    }
    PG8_WAIT_V(0);
    if (wr == 0) PG8_BAR;
    PG8_BAR;
    if constexpr (Epi::AFTER_DRAIN) { E.fused(acc, cur, wr, wc, fr, fq, lds, wid, lane); S.done(cur); }
    PG8_STAMP();
    if (STAMP && wid == 0) { stamps[lane] = lane < nts ? (((unsigned long long)(unsigned)ts_hi << 32) | (unsigned)ts_lo) : 0ull;
        if (lane == 62) stamps[62] = rt_entry; if (lane == 63) stamps[63] = (unsigned long long)wall_clock64(); }
#undef PG8_STAMP
#undef PG8_SA
#undef PG8_SB
#undef PG8_STAGE
#undef PG8_LDA
#undef PG8_LDB
#undef PG8_MMA
#undef PG8_WAIT_V
#undef PG8_WAIT_L
#undef PG8_BAR
#undef PG8_SCHED
}
}
#define LAS __attribute__((address_space(3)))
#define XB_TMO      128
#define XB_XCNT(j)  (256  + 64 * (j))
#define XB_XSUB(j)  (1280 + 64 * (j))
#define XB_XGEN(j)  (2304 + 64 * (j))
#define XB_TOP      3328
#define XB_TOPGEN   3392
#define XCD_BAR_WORDS 3456
#define XB_SPIN_CAP (1u << 18)


__device__ __forceinline__ unsigned xb_ld(unsigned* p)              { return __hip_atomic_load(p, __ATOMIC_RELAXED, __HIP_MEMORY_SCOPE_AGENT); }
__device__ __forceinline__ unsigned xb_add(unsigned* p, unsigned v) { return __hip_atomic_fetch_add(p, v, __ATOMIC_RELAXED, __HIP_MEMORY_SCOPE_AGENT); }
__device__ __forceinline__ unsigned xb_xcc_id() { return (unsigned)__builtin_amdgcn_s_getreg((3 << 11) | 20) & 0xFu; }
#define XB_SPIN(cond, bar) do { unsigned _sp = 0; while (cond) { __builtin_amdgcn_s_sleep(1); \
    if ((++_sp & 255u) == 0u) { if (xb_ld(&(bar)[XB_TMO])) break; if (_sp > XB_SPIN_CAP) { atomicAdd(&(bar)[XB_TMO], 1u); break; } } } } while (0)

struct XcdBarrier {
    unsigned* bar; unsigned x;
    volatile LAS unsigned* st;
};

__device__ __forceinline__ XcdBarrier xcd_barrier_post(unsigned* bar, volatile LAS unsigned* st) {
    XcdBarrier b; b.bar = bar; b.x = xb_xcc_id(); b.st = st;
    if (threadIdx.x == 0) (void)xb_add(&bar[XB_XCNT(b.x)], 1u);
    return b;
}
__device__ __forceinline__ void xcd_barrier_complete(unsigned* bar, unsigned x, unsigned& nloc, unsigned& nx) {
    const unsigned G = gridDim.x * gridDim.y * gridDim.z;
    unsigned sum, cnt, mine, sp = 0u;
    for (;;) {
        sum = 0u; cnt = 0u; mine = 0u;
#pragma unroll
        for (unsigned j = 0; j < 16; ++j) { const unsigned c = xb_ld(&bar[XB_XCNT(j)]); sum += c; cnt += (c > 0u) ? 1u : 0u; mine = (j == x) ? c : mine; }
        if (sum == G) break;
        __builtin_amdgcn_s_sleep(1);
        if ((++sp & 255u) == 0u) { if (xb_ld(&bar[XB_TMO])) break; if (sp > XB_SPIN_CAP) { atomicAdd(&bar[XB_TMO], 1u); break; } }
    }
    nloc = mine > 0u ? mine : 1u; nx = cnt > 0u ? cnt : 1u;
}

__device__ __forceinline__ void xcd_barrier(const XcdBarrier& b) {
    asm volatile("s_waitcnt vmcnt(0)" ::: "memory");
    __syncthreads();
    if (threadIdx.x == 0) {
        unsigned* bar = b.bar;
        __builtin_amdgcn_s_waitcnt(0);
        unsigned nloc = b.st[0], nx = b.st[1];
        if (nloc == 0u) { xcd_barrier_complete(bar, b.x, nloc, nx); b.st[0] = nloc; b.st[1] = nx; }
        const unsigned old = xb_add(&bar[XB_XSUB(b.x)], 1u);
        const unsigned gen = old / nloc;
        if (old + 1u == (gen + 1u) * nloc) {
            __builtin_amdgcn_fence(__ATOMIC_RELEASE, "agent");
            asm volatile("s_waitcnt vmcnt(0)" ::: "memory");
            const unsigned og = xb_add(&bar[XB_TOP], 1u);
            const unsigned tg = og / nx;
            if (og + 1u == (tg + 1u) * nx) xb_add(&bar[XB_TOPGEN], 1u);
            else XB_SPIN(xb_ld(&bar[XB_TOPGEN]) == tg, bar);
            __builtin_amdgcn_fence(__ATOMIC_ACQUIRE, "agent");
            xb_add(&bar[XB_XGEN(b.x)], 1u);
            asm volatile("s_waitcnt vmcnt(0)" ::: "memory");
        } else {
            XB_SPIN(xb_ld(&bar[XB_XGEN(b.x)]) == gen, bar);
            __builtin_amdgcn_fence(__ATOMIC_ACQUIRE, "agent");
            asm volatile("s_waitcnt vmcnt(0)" ::: "memory");
        }
    }
    __syncthreads();
}

using pg8::bf16_t; using pg8::bf16x8; using pg8::f32x4; using pg8::u32x4; using pg8::Unit; using pg8::BM; using pg8::HALF;
typedef float f32x2 __attribute__((ext_vector_type(2)));
typedef unsigned u32x2 __attribute__((ext_vector_type(2)));
typedef _Float16 f16x4 __attribute__((ext_vector_type(4)));

constexpr int D = 1024, FF = 2816, NIN = 1536, GWID = 512, DEPTH = 4;
constexpr int SEQ = 2048, NB = 8, MP = NB * SEQ, MS = 128, MV = MP + MS, MPAD = 16640;
constexpr int NTHR = 512, NWAVES = 8;
constexpr int LDS_STAGE = 131072, LDS_BYTES = LDS_STAGE + 16;
constexpr float LN_EPS = 1e-5f;
constexpr float ALPHA = 1.6817928305074292f;

constexpr size_t W_GU1 = 0, W_D1 = W_GU1 + (size_t)2 * FF * D, W_IN = W_D1 + (size_t)FF * D, W_OUT = W_IN + (size_t)NIN * D,
                 W_GU2 = W_OUT + (size_t)D * D, W_D2 = W_GU2 + (size_t)2 * FF * D, W_LAYER = W_D2 + (size_t)FF * D;
constexpr size_t WS_W = 0;
constexpr size_t WS_SMALL = WS_W + W_LAYER * 2 * DEPTH;
constexpr size_t SMALL_LAYER = 32768 * 2 + 65536;
constexpr size_t WS_X = WS_SMALL + SMALL_LAYER * 2 * DEPTH;
constexpr size_t WS_XN = WS_X + (size_t)MPAD * D * 4;
constexpr size_t WS_HP = WS_XN + (size_t)MPAD * D * 2;
constexpr size_t WS_MIX = WS_HP + (size_t)MPAD * NIN * 4;
constexpr size_t WS_AGG = WS_MIX + (size_t)MPAD * D * 2;
constexpr size_t WS_BAR = WS_AGG + (size_t)NB * 32 * 2 * 512 * 4;
constexpr size_t WS_PART = WS_BAR + 16384;
constexpr size_t WS_END = WS_PART + (size_t)4 * MS * D * 4;
static_assert((size_t)MPAD * FF * 2 <= (size_t)MPAD * NIN * 4, "hid fits in the proj region");
static_assert(WS_END <= 408000000ull, "workspace budget");

constexpr size_t O_Y = 0, O_PH = (size_t)MV * D, O_PC = O_PH + (size_t)DEPTH * NB * GWID, O_PP = O_PC + (size_t)DEPTH * NB * 3 * GWID,
                 O_SH = O_PP + (size_t)DEPTH * NB * 15 * GWID, O_SC = O_SH + (size_t)DEPTH * MS * GWID, O_SP = O_SC + (size_t)DEPTH * MS * 3 * GWID;

struct Params { const float* in[24]; float* out; unsigned char* ws; };
typedef const Params __attribute__((address_space(4))) CParams;
enum { I_XP = 0, I_XS, I_SH, I_SC, I_SP, I_LNG, I_LNB, I_W1G, I_W1U, I_W1D, I_WIN, I_CW, I_CB, I_GAW, I_GAB, I_GXW, I_GXB, I_LAM, I_PW, I_PS, I_WOUT, I_W2G, I_W2U, I_W2D };

__device__ __forceinline__ unsigned pk2(float lo, float hi) { return pg8::cvt_pk_bf16(lo, hi); }
__device__ __forceinline__ bf16_t f2bf(float f) { return (bf16_t)(pg8::cvt_pk_bf16(f, 0.f) & 0xffffu); }
__device__ __forceinline__ float wave_sum(float v) {
#pragma unroll
    for (int o = 1; o < 64; o <<= 1) v += __shfl_xor(v, o);
    return v;
}
__device__ __forceinline__ float sigmoidf_(float x) { return __builtin_amdgcn_rcpf(1.0f + __expf(-x)); }
__device__ __forceinline__ float gelu_tanh(float x) {
    const float z = 0.7978845608028654f * (x + 0.044715f * x * x * x);
    const float e = __expf(2.0f * z);
    const float th = 1.0f - 2.0f * __builtin_amdgcn_rcpf(e + 1.0f);
    return 0.5f * x * (1.0f + th);
}

struct EpiSwiglu {
    static constexpr bool PERM = true, AFTER_DRAIN = false;
    bf16_t* O; int ldc;
    __device__ __forceinline__ void operator()(const f32x4 (&acc)[2][2][4][2], const Unit& u, int wr, int wc, int fr, int fq) const {
        const int row0 = u.pm * BM + wr * 64 + fr, col0 = u.pn * 128 + wc * 32 + 8 * fq;
#pragma unroll
        for (int ai = 0; ai < 2; ++ai)
#pragma unroll
            for (int m = 0; m < 4; ++m) {
                bf16_t* rowp = O + (size_t)(row0 + ai * HALF + m * 16) * ldc + col0;
                float h[8];
#pragma unroll
                for (int n = 0; n < 2; ++n)
#pragma unroll
                    for (int j = 0; j < 4; ++j) { const float g = acc[ai][0][m][n][j], up = acc[ai][1][m][n][j]; h[n * 4 + j] = g * __builtin_amdgcn_rcpf(1.0f + __expf(-g)) * up; }
                u32x4 w; w.x = pk2(h[0], h[1]); w.y = pk2(h[2], h[3]); w.z = pk2(h[4], h[5]); w.w = pk2(h[6], h[7]);
                *(u32x4*)rowp = w;
            }
    }
};
struct EpiResid {
    static constexpr bool PERM = false, AFTER_DRAIN = false;
    float* X; int ldc; float alpha, coef;
    __device__ __forceinline__ void operator()(const f32x4 (&acc)[2][2][4][2], const Unit& u, int wr, int wc, int fr, int fq) const {
        const int row0 = u.pm * BM + wr * 64 + fr, col0 = u.pn * BM + wc * 32 + 4 * fq;
#pragma unroll
        for (int ai = 0; ai < 2; ++ai)
#pragma unroll
            for (int m = 0; m < 4; ++m) { float* rowp = X + (size_t)(row0 + ai * HALF + m * 16) * ldc + col0;
#pragma unroll
                for (int bj = 0; bj < 2; ++bj)
#pragma unroll
                    for (int n = 0; n < 2; ++n) { f32x4* p = (f32x4*)(rowp + bj * HALF + n * 16); const f32x4 v = *p; *p = v * alpha + acc[ai][bj][m][n] * coef; } }
    }
};

__device__ __forceinline__ void transpose_item(const float* W, int K, int N, bf16_t* WT, int mode, LAS float* scr, int item, int lane) {
    const int nblk = N / 32, kb = item / nblk, nb = item % nblk, k0 = 64 * kb, n0 = 32 * nb;
    const int drow0 = mode == 0 ? n0 : (256 * (n0 >> 7) + (n0 & 127) + (mode == 2 ? 128 : 0));
#pragma unroll
    for (int i = 0; i < 32; ++i) { const int kk = 2 * i + (lane >> 5); scr[kk * 33 + (lane & 31)] = W[(size_t)(k0 + kk) * N + n0 + (lane & 31)]; }
    asm volatile("s_waitcnt lgkmcnt(0)" ::: "memory");
    const int c = lane & 7;
#pragma unroll
    for (int j = 0; j < 4; ++j) { const int n = (lane >> 3) + 8 * j; const LAS float* s = scr + (8 * c) * 33 + n;
        u32x4 o; o.x = pk2(s[0 * 33], s[1 * 33]); o.y = pk2(s[2 * 33], s[3 * 33]); o.z = pk2(s[4 * 33], s[5 * 33]); o.w = pk2(s[6 * 33], s[7 * 33]);
        *(u32x4*)(WT + (size_t)(drow0 + n) * K + k0 + 8 * c) = o; }
    asm volatile("s_waitcnt lgkmcnt(0)" ::: "memory");
}
__device__ __forceinline__ void prologue(CParams* P, LAS unsigned char* lds, int gw, int NGW, int wave, int lane) {
    LAS float* scr = (LAS float*)(lds + wave * 16384);
    bf16_t* Wb = (bf16_t*)(P->ws + WS_W);
    constexpr int I_G = (D / 64) * (FF / 32), I_DN = (FF / 64) * (D / 32), I_I = (D / 64) * (NIN / 32), I_O = (D / 64) * (D / 32);
    constexpr int PER_LAYER = 4 * I_G + 2 * I_DN + I_I + I_O;
    for (int it = gw; it < PER_LAYER * DEPTH; it += NGW) {
        const int l = it / PER_LAYER; int r = it % PER_LAYER; bf16_t* WL = Wb + (size_t)l * W_LAYER;
        if (r < I_G) { transpose_item(P->in[I_W1G] + (size_t)l * D * FF, D, FF, WL + W_GU1, 1, scr, r, lane); continue; } r -= I_G;
        if (r < I_G) { transpose_item(P->in[I_W1U] + (size_t)l * D * FF, D, FF, WL + W_GU1, 2, scr, r, lane); continue; } r -= I_G;
        if (r < I_DN) { transpose_item(P->in[I_W1D] + (size_t)l * D * FF, FF, D, WL + W_D1, 0, scr, r, lane); continue; } r -= I_DN;
        if (r < I_I) { transpose_item(P->in[I_WIN] + (size_t)l * D * NIN, D, NIN, WL + W_IN, 0, scr, r, lane); continue; } r -= I_I;
        if (r < I_O) { transpose_item(P->in[I_WOUT] + (size_t)l * D * D, D, D, WL + W_OUT, 0, scr, r, lane); continue; } r -= I_O;
        if (r < I_G) { transpose_item(P->in[I_W2G] + (size_t)l * D * FF, D, FF, WL + W_GU2, 1, scr, r, lane); continue; } r -= I_G;
        if (r < I_G) { transpose_item(P->in[I_W2U] + (size_t)l * D * FF, D, FF, WL + W_GU2, 2, scr, r, lane); continue; } r -= I_G;
        transpose_item(P->in[I_W2D] + (size_t)l * D * FF, FF, D, WL + W_D2, 0, scr, r, lane);
    }
    bf16_t* Sm = (bf16_t*)(P->ws + WS_SMALL);
    const int gt = gw * 64 + lane, NGT = NGW * 64;
    for (int o = gt; o < DEPTH * 32768; o += NGT) {
        const int l = o / 32768, rem = o % 32768, h = rem / 4096, j = (rem / 64) % 64, i = rem % 64;
        const size_t src = (size_t)l * 32768 + h * 4096 + i * 64 + j;
        Sm[(size_t)l * SMALL_LAYER + rem] = f2bf(P->in[I_GAW][src]);
        Sm[(size_t)l * SMALL_LAYER + 32768 + rem] = f2bf(P->in[I_GXW][src]);
    }
    for (int o = gt; o < DEPTH * 65536; o += NGT) {
        const int l = o / 65536, rem = o % 65536, g = rem / 16384, j = (rem / 128) % 128, i = rem % 128;
        Sm[(size_t)l * SMALL_LAYER + 65536 + rem] = f2bf(P->in[I_PW][(size_t)l * 65536 + g * 16384 + i * 128 + j]);
    }
    for (int o = gt; o < DEPTH * MS * 2 * (GWID / 4); o += NGT) { const int c4 = o % (GWID / 4), k = (o / (GWID / 4)) % 2, lb = o / (2 * (GWID / 4));
        *(f32x4*)(P->out + O_SC + ((size_t)lb * 3 + k) * GWID + 4 * c4) = *(const f32x4*)(P->in[I_SC] + ((size_t)lb * 3 + k + 1) * GWID + 4 * c4); }
    for (int o = gt; o < DEPTH * MS * 14 * (GWID / 4); o += NGT) { const int c4 = o % (GWID / 4), k = (o / (GWID / 4)) % 14, lb = o / (14 * (GWID / 4));
        *(f32x4*)(P->out + O_SP + ((size_t)lb * 15 + k) * GWID + 4 * c4) = *(const f32x4*)(P->in[I_SP] + ((size_t)lb * 15 + k + 1) * GWID + 4 * c4); }
    float* X = (float*)(P->ws + WS_X); bf16_t* XN = (bf16_t*)(P->ws + WS_XN);
    for (int m = gw; m < MV; m += NGW) {
        const float* src = m < MP ? P->in[I_XP] + (size_t)m * D : P->in[I_XS] + (size_t)(m - MP) * D;
        const f32x4* xr = (const f32x4*)src + lane; f32x4* xo = (f32x4*)(X + (size_t)m * D) + lane; u32x2* o8 = (u32x2*)(XN + (size_t)m * D) + lane;
#pragma unroll
        for (int j = 0; j < 4; ++j) { const f32x4 v = xr[64 * j]; xo[64 * j] = v; u32x2 w; w.x = pk2(v[0], v[1]); w.y = pk2(v[2], v[3]); o8[64 * j] = w; }
    }
}

__device__ __forceinline__ void sample_skinny(const bf16_t* A  , const bf16_t* Bt  , int K, float* part, int bid, int wave, int fr, int fq) {
    if (bid >= 256) return;
    const int cb = bid & 63, ks = bid >> 6, Ks = K >> 2, n0 = 16 * cb;
    const bf16_t* ap = A + (size_t)(16 * wave + fr) * K + ks * Ks + 8 * fq;
    const bf16_t* bp = Bt + (size_t)(n0 + fr) * K + ks * Ks + 8 * fq;
    f32x4 acc = (f32x4){0.f, 0.f, 0.f, 0.f};
    const int nk = Ks >> 5;
    int kb = 0;
    for (; kb + 8 <= nk; kb += 8) {
        bf16x8 a[8], bb[8];
#pragma unroll
        for (int i = 0; i < 8; ++i) { a[i] = *(const bf16x8*)(ap + (kb + i) * 32); bb[i] = *(const bf16x8*)(bp + (kb + i) * 32); }
#pragma unroll
        for (int i = 0; i < 8; ++i) acc = __builtin_amdgcn_mfma_f32_16x16x32_bf16(bb[i], a[i], acc, 0, 0, 0);
    }
    for (; kb < nk; ++kb) { const bf16x8 a = *(const bf16x8*)(ap + kb * 32), bb = *(const bf16x8*)(bp + kb * 32); acc = __builtin_amdgcn_mfma_f32_16x16x32_bf16(bb, a, acc, 0, 0, 0); }
    *(f32x4*)(part + ((size_t)ks * MS + 16 * wave + fr) * D + n0 + 4 * fq) = acc;
}

__device__ __forceinline__ void ln_pass(float* X, bf16_t* XN, float* OUT, const float* g, const float* b, const float* part, float coef, int gw, int NGW, int lane) {
    f32x4 gg[4], bb[4];
#pragma unroll
    for (int j = 0; j < 4; ++j) { gg[j] = ((const f32x4*)g)[lane + 64 * j]; bb[j] = ((const f32x4*)b)[lane + 64 * j]; }
    for (int m = gw; m < MV; m += NGW) {
        const f32x4* xr = (const f32x4*)(X + (size_t)m * D) + lane;
        f32x4 v[4]; float s = 0.f;
#pragma unroll
        for (int j = 0; j < 4; ++j) v[j] = xr[64 * j];
        if (m >= MP) {
#pragma unroll
            for (int j = 0; j < 4; ++j) { f32x4 a = (f32x4){0.f, 0.f, 0.f, 0.f};
#pragma unroll
                for (int ks = 0; ks < 4; ++ks) a += ((const f32x4*)(part + ((size_t)ks * MS + (m - MP)) * D) + lane)[64 * j];
                v[j] = v[j] * ALPHA + a * coef; }
        }
#pragma unroll
        for (int j = 0; j < 4; ++j) s += (v[j][0] + v[j][1]) + (v[j][2] + v[j][3]);
        const float mean = wave_sum(s) * (1.f / D); float s2 = 0.f;
#pragma unroll
        for (int j = 0; j < 4; ++j) { v[j] = v[j] - mean; s2 += (v[j][0] * v[j][0] + v[j][1] * v[j][1]) + (v[j][2] * v[j][2] + v[j][3] * v[j][3]); }
        const float rstd = 1.0f / sqrtf(wave_sum(s2) * (1.f / D) + LN_EPS);
        f32x4* xo = (f32x4*)((OUT ? OUT : X) + (size_t)m * D) + lane; u32x2* o8 = (u32x2*)(XN + (size_t)m * D) + lane;
#pragma unroll
        for (int j = 0; j < 4; ++j) { const f32x4 y = v[j] * rstd * gg[j] + bb[j]; xo[64 * j] = y; u32x2 w; w.x = pk2(y[0], y[1]); w.y = pk2(y[2], y[3]); o8[64 * j] = w; }
    }
}

constexpr int XCS = 520;
constexpr int XC_OFF = 0, R_OFF = 32 * XCS * 2, I_OFF = 2 * 32 * XCS * 2;

__device__ __forceinline__ void gates_mfma(LAS unsigned char* lds, const bf16_t* WaT, const bf16_t* WxT, const float* ba, const float* bx, int h, int fr, int fq) {
    bf16x8 A[2][2];
#pragma unroll
    for (int mb = 0; mb < 2; ++mb)
#pragma unroll
        for (int kb = 0; kb < 2; ++kb) A[mb][kb] = *(const LAS bf16x8*)(lds + XC_OFF + ((mb * 16 + fr) * XCS + 64 * h + kb * 32 + 8 * fq) * 2);
#pragma unroll
    for (int gate = 0; gate < 2; ++gate) {
        const bf16_t* W = (gate ? WxT : WaT) + h * 4096; const float* bias = (gate ? bx : ba) + 64 * h; const int ooff = gate ? I_OFF : R_OFF;
#pragma unroll
        for (int nb = 0; nb < 4; ++nb) {
            const bf16x8 B0 = *(const bf16x8*)(W + (nb * 16 + fr) * 64 + 8 * fq), B1 = *(const bf16x8*)(W + (nb * 16 + fr) * 64 + 32 + 8 * fq);
            const f32x4 bv = *(const f32x4*)(bias + nb * 16 + 4 * fq);
#pragma unroll
            for (int mb = 0; mb < 2; ++mb) {
                f32x4 acc = (f32x4){0.f, 0.f, 0.f, 0.f};
                acc = __builtin_amdgcn_mfma_f32_16x16x32_bf16(B0, A[mb][0], acc, 0, 0, 0);
                acc = __builtin_amdgcn_mfma_f32_16x16x32_bf16(B1, A[mb][1], acc, 0, 0, 0);
                acc = acc + bv;
                f16x4 hv; hv[0] = (_Float16)sigmoidf_(acc[0]); hv[1] = (_Float16)sigmoidf_(acc[1]); hv[2] = (_Float16)sigmoidf_(acc[2]); hv[3] = (_Float16)sigmoidf_(acc[3]);
                *(LAS f16x4*)(lds + ooff + ((mb * 16 + fr) * XCS + 64 * h + nb * 16 + 4 * fq) * 2) = hv;
            }
        }
    }
}
template <int NMB>
__device__ __forceinline__ void pool_mfma(LAS unsigned char* lds, const bf16_t* PWT, const float* pscale, bf16_t* mixrow, int w, int fr, int fq) {
    const int g = w >> 1, half = w & 1;
    f32x4 acc[NMB][4];
#pragma unroll
    for (int mb = 0; mb < NMB; ++mb)
#pragma unroll
        for (int nb = 0; nb < 4; ++nb) acc[mb][nb] = (f32x4){0.f, 0.f, 0.f, 0.f};
#pragma unroll
    for (int kb = 0; kb < 4; ++kb) {
        bf16x8 A[NMB];
#pragma unroll
        for (int mb = 0; mb < NMB; ++mb) A[mb] = *(const LAS bf16x8*)(lds + ((mb * 16 + fr) * XCS + 128 * g + kb * 32 + 8 * fq) * 2);
#pragma unroll
        for (int nb = 0; nb < 4; ++nb) {
            const bf16x8 B = *(const bf16x8*)(PWT + ((size_t)g * 128 + 64 * half + nb * 16 + fr) * 128 + kb * 32 + 8 * fq);
#pragma unroll
            for (int mb = 0; mb < NMB; ++mb) acc[mb][nb] = __builtin_amdgcn_mfma_f32_16x16x32_bf16(B, A[mb], acc[mb][nb], 0, 0, 0);
        }
    }
#pragma unroll
    for (int nb = 0; nb < 4; ++nb) {
        const int ch = 128 * g + 64 * half + nb * 16 + 4 * fq; const f32x4 sc = *(const f32x4*)(pscale + ch);
#pragma unroll
        for (int mb = 0; mb < NMB; ++mb) { const f32x4 v = acc[mb][nb] * sc; u32x2 o; o.x = pk2(v[0], v[1]); o.y = pk2(v[2], v[3]);
            *(u32x2*)(mixrow + (size_t)(mb * 16 + fr) * D + GWID + ch) = o; }
    }
}
template <int W>
__device__ __forceinline__ void pool_prompt_thread(const float* UP, int t0, LAS bf16_t* PL, int c) {
    float hist[W - 1], v[64]; float s = 0.f;
#pragma unroll
    for (int k = 0; k < W - 1; ++k) hist[k] = (t0 > 0) ? (UP + (k - (W - 1)) * NIN)[c] : 0.f;
#pragma unroll
    for (int t = 0; t < 64; ++t) v[t] = (UP + t * NIN)[c];
#pragma unroll
    for (int k = 0; k < W - 1; ++k) s += hist[k];
#pragma unroll
    for (int t = 0; t < 64; ++t) {
        s += v[t];
        const float rc = (t >= W - 1 || t0 > 0) ? (1.0f / (float)W) : (1.0f / (float)(t + 1));
        PL[t * XCS + c] = f2bf(s * rc - v[t]);
        s -= (t - W + 1 >= 0) ? v[t - W + 1 >= 0 ? t - W + 1 : 0] : hist[t < W - 1 ? t : 0];
    }
}
template <int W>
__device__ __forceinline__ void pool_sample_thread(const float* UP, const float* SPs, float* SPo, LAS bf16_t* PL, int c) {
    float v[32];
#pragma unroll
    for (int t = 0; t < 32; ++t) v[t] = (UP + (size_t)t * NIN)[c];
#pragma unroll
    for (int t0 = 0; t0 < 32; t0 += 4) {
        float q[4][W - 1];
#pragma unroll
        for (int t = 0; t < 4; ++t)
#pragma unroll
            for (int k = 0; k < W - 1; ++k) q[t][k] = (SPs + ((size_t)(t0 + t) * 15 + (16 - W) + k) * GWID)[c];
#pragma unroll
        for (int t = 0; t < 4; ++t) { float s = v[t0 + t];
#pragma unroll
            for (int k = 0; k < W - 1; ++k) s += q[t][k];
            PL[(t0 + t) * XCS + c] = f2bf(s * (1.0f / (float)W) - v[t0 + t]); }
    }
#pragma unroll
    for (int t = 0; t < 32; ++t) (SPo + ((size_t)t * 15 + 14) * GWID)[c] = v[t];
}

struct MixW {
    const float *cw, *cb, *gab, *gxb, *lam, *psc; const bf16_t *GAT, *GXT, *PWT;
};

__global__ void __launch_bounds__(NTHR, 2) fwd_megakernel(Params p) {
    extern __shared__ __attribute__((aligned(16))) unsigned char lds_raw[];
    LAS unsigned char* lds = (LAS unsigned char*)lds_raw;
    cg::grid_group grid = cg::this_grid();
    const int G0 = gridDim.x, bid0 = blockIdx.x;

#ifdef TIME_CLASS
    const unsigned long long t_pro0 = __builtin_amdgcn_s_memrealtime();
#endif
    if (threadIdx.x == 0) { ((LAS unsigned*)(lds + LDS_STAGE))[0] = 0u; ((LAS unsigned*)(lds + LDS_STAGE))[1] = 0u; }
    __syncthreads();
    (void)xcd_barrier_post((unsigned*)(((CParams*)__builtin_amdgcn_kernarg_segment_ptr())->ws + WS_BAR), (volatile LAS unsigned*)(lds + LDS_STAGE));
#define GSYNC() do { XcdBarrier b_; b_.bar = (unsigned*)(ws + WS_BAR); b_.x = xb_xcc_id(); b_.st = (volatile LAS unsigned*)(lds + LDS_STAGE); xcd_barrier(b_); } while (0)
    { const int tid = threadIdx.x, lane = tid & 63, wave = __builtin_amdgcn_readfirstlane(tid >> 6);
      prologue((CParams*)__builtin_amdgcn_kernarg_segment_ptr(), lds, bid0 * NWAVES + wave, G0 * NWAVES, wave, lane); }
    if (G0 == 0x7fffffff) grid.sync();
    { unsigned char* const ws = ((CParams*)__builtin_amdgcn_kernarg_segment_ptr())->ws; GSYNC(); }

    constexpr int NK = 10;
#ifdef TIME_CLASS
    unsigned long long t_acc = (TIME_CLASS == 5) ? (__builtin_amdgcn_s_memrealtime() - t_pro0) : 0ull;
#endif
    for (int ph = 0; ph < DEPTH * NK; ++ph) {
        const int l = ph / NK, kind = ph % NK;
#ifdef TIME_CLASS
        const unsigned long long t_beg = __builtin_amdgcn_s_memrealtime();
#endif
        int G = G0, bid = bid0; asm volatile("" : "+s"(G), "+s"(bid));
        const int NGW = G * NWAVES;
        int tid = threadIdx.x; asm volatile("" : "+v"(tid));
        const int lane = tid & 63, wave = __builtin_amdgcn_readfirstlane(tid >> 6), fr = lane & 15, fq = lane >> 4, gw = bid * NWAVES + wave;
        CParams* P = (CParams*)__builtin_amdgcn_kernarg_segment_ptr(); asm volatile("" : "+s"(P));
        unsigned char* const ws = P->ws;
        float* X = (float*)(ws + WS_X); bf16_t* XN = (bf16_t*)(ws + WS_XN); bf16_t* HID = (bf16_t*)(ws + WS_HP); float* PROJ = (float*)(ws + WS_HP);
        bf16_t* MIX = (bf16_t*)(ws + WS_MIX); float* AGG = (float*)(ws + WS_AGG);
        const bf16_t* Wb = (const bf16_t*)(ws + WS_W); const bf16_t* Sm = (const bf16_t*)(ws + WS_SMALL);
        const bf16_t* WL = Wb + (size_t)l * W_LAYER;
        if (kind == 0 || kind == 7) {
            pg8::Gemm g{XN, WL + (kind == 0 ? W_GU1 : W_GU2), MPAD, 2 * FF, D}; pg8::StaticOrder S; S.init(MPAD, 2 * FF, G, bid);
            EpiSwiglu E{HID, FF};
            pg8::gemm_phase<EpiSwiglu, pg8::StaticOrder>(lds, g, S, E, nullptr);
        } else if (kind == 1 || kind == 8 || kind == 5) {
            const bool wo = (kind == 5);
            const bf16_t* Bw = WL + (wo ? W_OUT : (kind == 1 ? W_D1 : W_D2)); const int Kd = wo ? D : FF;
            sample_skinny((wo ? MIX : HID) + (size_t)MP * Kd, Bw, Kd, (float*)(ws + WS_PART), bid, wave, fr, fq);
            pg8::Gemm g{wo ? MIX : HID, Bw, MP, D, Kd}; pg8::StaticOrder S; S.init(MP, D, G, bid);
            EpiResid E{X, D, ALPHA, wo ? 1.0f : 0.5f};
            pg8::gemm_phase<EpiResid, pg8::StaticOrder>(lds, g, S, E, nullptr);
        } else if (kind == 3) {
            pg8::Gemm g{XN, WL + W_IN, MPAD, NIN, D}; pg8::StaticOrder S; S.init(MPAD, NIN, G, bid);
            pg8::EpiF32 E{PROJ, NIN, nullptr};
            pg8::gemm_phase<pg8::EpiF32, pg8::StaticOrder>(lds, g, S, E, nullptr);
        } else if (kind == 2 || kind == 6 || kind == 9) {
            const int which = kind == 2 ? 0 : (kind == 6 ? 1 : 2);
            const bool fin = (l == DEPTH - 1 && which == 2);
            ln_pass(X, XN, fin ? P->out + O_Y : nullptr, P->in[I_LNG] + (size_t)(l * 3 + which) * D, P->in[I_LNB] + (size_t)(l * 3 + which) * D, (const float*)(ws + WS_PART), which == 1 ? 1.0f : 0.5f, gw, NGW, lane);
        } else {
            MixW mw; mw.cw = P->in[I_CW] + (size_t)l * 4 * GWID; mw.cb = P->in[I_CB] + (size_t)l * GWID; mw.gab = P->in[I_GAB] + (size_t)l * GWID; mw.gxb = P->in[I_GXB] + (size_t)l * GWID;
            mw.lam = P->in[I_LAM] + (size_t)l * GWID; mw.psc = P->in[I_PS] + (size_t)l * GWID;
            mw.GAT = Sm + (size_t)l * SMALL_LAYER; mw.GXT = mw.GAT + 32768; mw.PWT = mw.GAT + 65536;
            const int c = tid;
            const bool has = bid < NB * 32;
            const int b = bid >> 5, j = bid & 31, t0 = j * 64; const size_t row0 = (size_t)b * SEQ + t0;
            const float cw0 = mw.cw[c], cw1 = mw.cw[GWID + c], cw2 = mw.cw[2 * GWID + c], cw3 = mw.cw[3 * GWID + c], cbv = mw.cb[c];
            const float lamv = mw.lam[c]; const float k8 = -8.0f * log1pf(__expf(-lamv));
            if (has) {
                const float* UP = PROJ + row0 * NIN + 2 * GWID; LAS bf16_t* PL = (LAS bf16_t*)lds;
                const int grp = wave >> 1;
                if (grp == 0) pool_prompt_thread<2>(UP, t0, PL, c); else if (grp == 1) pool_prompt_thread<4>(UP, t0, PL, c);
                else if (grp == 2) pool_prompt_thread<8>(UP, t0, PL, c); else pool_prompt_thread<16>(UP, t0, PL, c);
                if (j == 31) { float* o = P->out + O_PP + ((size_t)(l * NB + b) * 15) * GWID; float q[15];
#pragma unroll
                    for (int k = 0; k < 15; ++k) q[k] = (UP + (49 + k) * NIN)[c];
#pragma unroll
                    for (int k = 0; k < 15; ++k) (o + k * GWID)[c] = q[k]; }
                __syncthreads();
                pool_mfma<4>(lds, mw.PWT, mw.psc, MIX + row0 * D, wave, fr, fq);
                __syncthreads();
            }
            float hloc[64], cumA[64];
#pragma unroll
            for (int t = 0; t < 64; ++t) { hloc[t] = 0.f; cumA[t] = 0.f; }
            if (has) {
                float h = 0.f, cum = 1.f;
                const float* U = PROJ + row0 * NIN;
                float p0 = 0.f, p1 = 0.f, p2 = 0.f;
                if (j > 0) { p0 = (U - 3 * NIN)[c]; p1 = (U - 2 * NIN)[c]; p2 = (U - 1 * NIN)[c]; }
#pragma unroll
                for (int s = 0; s < 2; ++s) {
                    float xc[32];
                    { float u[32];
#pragma unroll
                      for (int t = 0; t < 32; ++t) u[t] = (U + (s * 32 + t) * NIN)[c];
#pragma unroll
                      for (int t = 0; t < 32; ++t) { const float v = u[t]; xc[t] = cbv + cw0 * p0 + cw1 * p1 + cw2 * p2 + cw3 * v; p0 = p1; p1 = p2; p2 = v;
                          ((LAS bf16_t*)(lds + XC_OFF))[t * XCS + c] = f2bf(xc[t]); } }
                    __syncthreads();
                    gates_mfma(lds, mw.GAT, mw.GXT, mw.gab, mw.gxb, wave, fr, fq);
                    __syncthreads();
#pragma unroll
                    for (int t = 0; t < 32; ++t) {
                        const float r = (float)((const LAS _Float16*)(lds + R_OFF))[t * XCS + c], ig = (float)((const LAS _Float16*)(lds + I_OFF))[t * XCS + c];
                        const float la = r * k8, a = __expf(la), mult = __builtin_amdgcn_sqrtf(fmaxf(1.0f - a * a, 0.0f)), uu = mult * (ig * xc[t]);
                        h = a * h + uu; cum *= a; hloc[s * 32 + t] = h; cumA[s * 32 + t] = cum;
                    }
                    __syncthreads();
                }
                (AGG + ((size_t)(b * 32 + j) * 2 + 0) * GWID)[c] = cum; (AGG + ((size_t)(b * 32 + j) * 2 + 1) * GWID)[c] = h;
                if (j == 31) { float* o = P->out + O_PC + ((size_t)(l * NB + b) * 3) * GWID; o[c] = p0; (o + GWID)[c] = p1; (o + 2 * GWID)[c] = p2; }
            }
            GSYNC();
            if (has) {
                float carry = 0.f;
#pragma unroll 8
                for (int i = 0; i < j; ++i) { const float A_ = (AGG + ((size_t)(b * 32 + i) * 2 + 0) * GWID)[c], H_ = (AGG + ((size_t)(b * 32 + i) * 2 + 1) * GWID)[c]; carry = A_ * carry + H_; }
                const float* UG = PROJ + row0 * NIN + GWID; bf16_t* mo = MIX + row0 * D;
#pragma unroll
                for (int s = 0; s < 2; ++s) {
                    float gt[32];
#pragma unroll
                    for (int t = 0; t < 32; ++t) gt[t] = (UG + (s * 32 + t) * NIN)[c];
#pragma unroll
                    for (int t = 0; t < 32; ++t) (mo + (size_t)(s * 32 + t) * D)[c] = f2bf((hloc[s * 32 + t] + cumA[s * 32 + t] * carry) * gelu_tanh(gt[t]));
                }
                if (j == 31) (P->out + O_PH + (size_t)(l * NB + b) * GWID)[c] = hloc[63] + cumA[63] * carry;
            }
            if (bid >= G - 4) {
                const int b0 = (bid - (G - 4)) * 32; const size_t srow0 = (size_t)MP + b0;
                __syncthreads();
                {
                    const float* UP = PROJ + srow0 * NIN + 2 * GWID; LAS bf16_t* PL = (LAS bf16_t*)lds;
                    const float* SPs = P->in[I_SP] + ((size_t)(l * MS + b0) * 15) * GWID; float* SPo = P->out + O_SP + ((size_t)(l * MS + b0) * 15) * GWID;
                    const int grp = wave >> 1;
                    if (grp == 0) pool_sample_thread<2>(UP, SPs, SPo, PL, c); else if (grp == 1) pool_sample_thread<4>(UP, SPs, SPo, PL, c);
                    else if (grp == 2) pool_sample_thread<8>(UP, SPs, SPo, PL, c); else pool_sample_thread<16>(UP, SPs, SPo, PL, c);
                    __syncthreads();
                    pool_mfma<2>(lds, mw.PWT, mw.psc, MIX + srow0 * D, wave, fr, fq);
                    __syncthreads();
                }
                {
                    float xc[32], h0[32], gt[32];
                    { float u[32];
#pragma unroll
                      for (int t = 0; t < 32; ++t) u[t] = (PROJ + (srow0 + t) * NIN)[c];
#pragma unroll
                      for (int t = 0; t < 32; ++t) xc[t] = cbv;
#pragma unroll
                      for (int k = 0; k < 3; ++k) { float sk[32]; const float wk = k == 0 ? cw0 : (k == 1 ? cw1 : cw2);
#pragma unroll
                          for (int t = 0; t < 32; ++t) sk[t] = (P->in[I_SC] + ((size_t)(l * MS + b0 + t) * 3 + k) * GWID)[c];
#pragma unroll
                          for (int t = 0; t < 32; ++t) xc[t] += wk * sk[t]; }
#pragma unroll
                      for (int t = 0; t < 32; ++t) { xc[t] += cw3 * u[t]; ((LAS bf16_t*)(lds + XC_OFF))[t * XCS + c] = f2bf(xc[t]); }
#pragma unroll
                      for (int t = 0; t < 32; ++t) (P->out + O_SC + ((size_t)(l * MS + b0 + t) * 3 + 2) * GWID)[c] = u[t]; }
#pragma unroll
                    for (int t = 0; t < 32; ++t) { h0[t] = (P->in[I_SH] + (size_t)(l * MS + b0 + t) * GWID)[c]; gt[t] = (PROJ + (srow0 + t) * NIN + GWID)[c]; }
                    __syncthreads();
                    gates_mfma(lds, mw.GAT, mw.GXT, mw.gab, mw.gxb, wave, fr, fq);
                    __syncthreads();
#pragma unroll
                    for (int t = 0; t < 32; ++t) {
                        const float r = (float)((const LAS _Float16*)(lds + R_OFF))[t * XCS + c], ig = (float)((const LAS _Float16*)(lds + I_OFF))[t * XCS + c];
                        const float la = r * k8, a = __expf(la), mult = __builtin_amdgcn_sqrtf(fmaxf(1.0f - a * a, 0.0f)), uu = mult * (ig * xc[t]);
                        const float hh = a * h0[t] + uu;
                        (P->out + O_SH + (size_t)(l * MS + b0 + t) * GWID)[c] = hh;
                        (MIX + (srow0 + t) * D)[c] = f2bf(hh * gelu_tanh(gt[t]));
                    }
                    __syncthreads();
                }
            }
        }
        if (ph != DEPTH * NK - 1) GSYNC();
#ifdef TIME_CLASS
        { const int cls = (kind == 0 || kind == 7) ? 0 : (kind == 1 || kind == 8) ? 1 : (kind == 3 || kind == 5) ? 2 : (kind == 4) ? 4 : 3;
          if (cls == TIME_CLASS) t_acc += __builtin_amdgcn_s_memrealtime() - t_beg; }
#endif
    }
#ifdef TIME_CLASS
    if (blockIdx.x == 0) { const unsigned long long t0 = __builtin_amdgcn_s_memrealtime(); while (__builtin_amdgcn_s_memrealtime() - t0 < t_acc) __builtin_amdgcn_s_sleep(8); }
#endif
}

extern "C" void kernel_launch(void* const* d_in, const int* in_sizes, int n_in, void* d_out, int out_size, void* d_ws, size_t ws_size, hipStream_t stream) {
    static int grid_blocks = 0;
    if (!grid_blocks) {
        int dev = 0, cus = 0, per_cu = 0;
        hipGetDevice(&dev);
        hipDeviceGetAttribute(&cus, hipDeviceAttributeMultiprocessorCount, dev);
        hipFuncSetAttribute((const void*)fwd_megakernel, hipFuncAttributeMaxDynamicSharedMemorySize, LDS_BYTES);
        hipOccupancyMaxActiveBlocksPerMultiprocessor(&per_cu, (const void*)fwd_megakernel, NTHR, LDS_BYTES);
        if (per_cu < 1) per_cu = 1;
        grid_blocks = cus * per_cu;
        if (grid_blocks > 256) grid_blocks = 256;
        if (ws_size < WS_END) fprintf(stderr, "kernel_launch: workspace too small: %zu < %zu\n", ws_size, (size_t)WS_END);
    }
    Params p{};
    for (int i = 0; i < 24; ++i) p.in[i] = (const float*)d_in[i];
    p.out = (float*)d_out; p.ws = (unsigned char*)d_ws;
    (void)hipMemsetAsync((unsigned char*)d_ws + WS_BAR, 0, 16384, stream);
    void* args[] = {&p};
    hipError_t e = hipLaunchCooperativeKernel((const void*)fwd_megakernel, dim3(grid_blocks), dim3(NTHR), args, LDS_BYTES, stream);
    if (e != hipSuccess) fprintf(stderr, "cooperative launch failed: %s (grid %d)\n", hipGetErrorString(e), grid_blocks);
}
```

```cpp
#include <hip/hip_runtime.h>
#include <hip/hip_cooperative_groups.h>
#include <cstdio>
namespace cg = cooperative_groups;
namespace pg8 {
#define PG8_LAS __attribute__((address_space(3)))
typedef unsigned short bf16_t;
typedef short bf16x8 __attribute__((ext_vector_type(8)));
typedef float f32x4 __attribute__((ext_vector_type(4)));
typedef unsigned u32x4 __attribute__((ext_vector_type(4)));
constexpr int BM = 256, BK = 64, HALF = 128, HTB = HALF * BK * 2  , STAGE_BYTES = 8 * HTB, NXCD = 8, WGM = 8;

__host__ __device__ __forceinline__ int lds_byte(int r, int c) { const int st = (r >> 4) * 2 + (c >> 5), rr = r & 15, cc = c & 31, ob = rr * 64 + cc * 2; return st * 1024 + (ob ^ (((ob >> 9) & 1) << 5)); }
__host__ __device__ __forceinline__ void stage_rc(int b, int& R, int& C) { const int st = b / 1024, sb = b % 1024, swz = sb ^ (((sb >> 9) & 1) << 5); R = (st >> 1) * 16 + swz / 64; C = (st & 1) * 32 + (swz % 64) / 2; }
__host__ __device__ __forceinline__ int perm32(int rho) { const int n = rho >> 4, i = rho & 15; return 8 * (i >> 2) + 4 * n + (i & 3); }

struct Unit { int pm, pn; };
struct Gemm { const bf16_t* A; const bf16_t* Bt; int M, N, K; };

struct StaticOrder {
    int nM, nN, nwg, G, c;
    __host__ __device__ void init(int M, int N, int G_, int c_) { nM = M / BM; nN = N / BM; nwg = nM * nN; G = G_; c = c_; }
    __host__ __device__ bool next(int i, Unit& u) const {
        const long L = (long)i * G + c; if (L >= nwg) return false;
        int wgid = (int)L; { const int q = nwg / NXCD, r = nwg % NXCD, xcd = wgid % NXCD, off = wgid / NXCD; wgid = (xcd < r ? xcd * (q + 1) : r * (q + 1) + (xcd - r) * q) + off; }
        const int nig = WGM * nN, gid = wgid / nig, fm = gid * WGM, gsz = (nM - fm) < WGM ? (nM - fm) : WGM;
        u.pm = fm + ((wgid % nig) % gsz); u.pn = (wgid % nig) / gsz; return true;
    }
    __device__ __forceinline__ void a_ready(const Unit&) const {}
    __device__ __forceinline__ void done(const Unit&) const {}
};
__device__ __forceinline__ unsigned cvt_pk_bf16(float lo, float hi) { unsigned r; asm volatile("v_cvt_pk_bf16_f32 %0, %1, %2" : "=v"(r) : "v"(lo), "v"(hi)); return r; }
typedef float f32x2 __attribute__((ext_vector_type(2)));
struct EpiF32 {
    static constexpr bool PERM = false, AFTER_DRAIN = false;
    float* C; int ldc; const float* bias;
    __device__ __forceinline__ void operator()(const f32x4 (&acc)[2][2][4][2], const Unit& u, int wr, int wc, int fr, int fq) const {
        const int row0 = u.pm * BM + wr * 64 + fr, col0 = u.pn * BM + wc * 32 + 4 * fq;
        f32x4 bv[2][2];
#pragma unroll
        for (int bj = 0; bj < 2; ++bj)
#pragma unroll
            for (int n = 0; n < 2; ++n) bv[bj][n] = bias ? *(const f32x4*)(bias + col0 + bj * HALF + n * 16) : (f32x4){0.f, 0.f, 0.f, 0.f};
#pragma unroll
        for (int ai = 0; ai < 2; ++ai)
#pragma unroll
            for (int m = 0; m < 4; ++m) { float* rowp = C + (size_t)(row0 + ai * HALF + m * 16) * ldc + col0;
#pragma unroll
                for (int bj = 0; bj < 2; ++bj)
#pragma unroll
                    for (int n = 0; n < 2; ++n) *(f32x4*)(rowp + bj * HALF + n * 16) = acc[ai][bj][m][n] + bv[bj][n]; }
    }
};
template <class Epi, class Sched, bool STAMP = false>
__device__ __forceinline__ void gemm_phase(PG8_LAS unsigned char* lds, const Gemm g, const Sched& S, const Epi& E, unsigned long long* stamps) {
    int tid_l = threadIdx.x; asm volatile("" : "+v"(tid_l));
    const int tid = tid_l, wid = __builtin_amdgcn_readfirstlane(tid >> 6), lane = tid & 63, wr = wid >> 2, wc = wid & 3, fr = lane & 15, fq = lane >> 4;
    const int K = g.K, nt = K / BK;
    int ts_lo = 0, ts_hi = 0, nts = 0; const unsigned long long rt_entry = STAMP ? (unsigned long long)wall_clock64() : 0ull;
#define PG8_STAMP() do { if (STAMP && wid == 0 && nts < 64) { const unsigned long long _c = (unsigned long long)clock64(); \
        ts_lo = (lane == nts) ? (int)(unsigned)_c : ts_lo; ts_hi = (lane == nts) ? (int)(unsigned)(_c >> 32) : ts_hi; ++nts; } } while (0)
    PG8_STAMP();
    unsigned voffA[2], voffB[2];
#pragma unroll
    for (int i = 0; i < 2; ++i) { int R, C; stage_rc(tid * 16 + i * 8192, R, C); const int Rb = Epi::PERM ? ((R & ~31) + perm32(R & 31)) : R;
        voffA[i] = (unsigned)(R * K + C) * 2u; voffB[i] = (unsigned)(Rb * K + C) * 2u; }
    const size_t kstep = (size_t)(BK * 2);
    const size_t hstep = (size_t)HALF * K * 2;
    const size_t tstep = 2 * hstep;
    const unsigned ldsw = (unsigned)wid * 1024u;
    const int aoff = lds_byte(wr * 64 + fr, fq * 8), boff = lds_byte(wc * 32 + fr, fq * 8);
#define PG8_SA(b, h) (((b) * 2 + (h)) * HTB)
#define PG8_SB(b, h) ((4 + (b) * 2 + (h)) * HTB)
#define PG8_STAGE(bufoff, gbase, voff) do { _Pragma("unroll") for (int _i = 0; _i < 2; ++_i) \
        __builtin_amdgcn_global_load_lds((const unsigned*)((const char*)(gbase) + (voff)[_i]), (PG8_LAS unsigned*)(lds + (bufoff) + ldsw + _i * 8192), 16, 0, 0); } while (0)
#define PG8_LDA(dst, b, h) do { _Pragma("unroll") for (int m = 0; m < 4; ++m) _Pragma("unroll") for (int k = 0; k < 2; ++k) dst[m][k] = *(const PG8_LAS bf16x8*)(lds + PG8_SA(b, h) + aoff + m * 2048 + k * 1024); } while (0)
#define PG8_LDB(dst, b, h) do { _Pragma("unroll") for (int n = 0; n < 2; ++n) _Pragma("unroll") for (int k = 0; k < 2; ++k) dst[n][k] = *(const PG8_LAS bf16x8*)(lds + PG8_SB(b, h) + boff + n * 2048 + k * 1024); } while (0)
#define PG8_MMA(ai, bj, At, Bt) do { __builtin_amdgcn_s_setprio(1); _Pragma("unroll") for (int m = 0; m < 4; ++m) _Pragma("unroll") for (int n = 0; n < 2; ++n) _Pragma("unroll") for (int k = 0; k < 2; ++k) \
        acc[ai][bj][m][n] = __builtin_amdgcn_mfma_f32_16x16x32_bf16(Bt[n][k], At[m][k], acc[ai][bj][m][n], 0, 0, 0); __builtin_amdgcn_s_setprio(0); } while (0)
#define PG8_WAIT_V(n) asm volatile("s_waitcnt vmcnt(" #n ")" ::: "memory")
#define PG8_WAIT_L(n) asm volatile("s_waitcnt lgkmcnt(" #n ")" ::: "memory")
#define PG8_BAR __builtin_amdgcn_s_barrier()
#define PG8_SCHED __builtin_amdgcn_sched_barrier(0)
    Unit cur, nxt; int ui = 0;
    if (!S.next(0, cur)) return;
    f32x4 acc[2][2][4][2];
#pragma unroll
    for (int a = 0; a < 2; ++a)
#pragma unroll
        for (int b = 0; b < 2; ++b)
#pragma unroll
            for (int m = 0; m < 4; ++m)
#pragma unroll
                for (int n = 0; n < 2; ++n) acc[a][b][m][n] = (f32x4){0.f, 0.f, 0.f, 0.f};
    bf16x8 At[4][2], B0[2][2], B1[2][2];
    const char* cA = (const char*)g.A + (size_t)cur.pm * tstep; const char* cB = (const char*)g.Bt + (size_t)cur.pn * tstep;
    S.a_ready(cur);
    PG8_STAGE(PG8_SB(0, 0), cB, voffB); PG8_STAGE(PG8_SA(0, 0), cA, voffA); PG8_STAGE(PG8_SB(0, 1), cB + hstep, voffB); PG8_STAGE(PG8_SA(0, 1), cA + hstep, voffA);
    if (wr == 1) PG8_BAR;
    PG8_WAIT_V(4); PG8_BAR;
    PG8_STAGE(PG8_SB(1, 0), cB + kstep, voffB); PG8_STAGE(PG8_SA(1, 0), cA + kstep, voffA); PG8_STAGE(PG8_SB(1, 1), cB + hstep + kstep, voffB);
    PG8_WAIT_V(6); PG8_BAR;
    PG8_STAMP();
    for (;;) {
        const bool has_next = S.next(ui + 1, nxt);
        const char* nA = has_next ? (const char*)g.A + (size_t)nxt.pm * tstep : cA; const char* nB = has_next ? (const char*)g.Bt + (size_t)nxt.pn * tstep : cB;
        for (int t = 0; t < nt; t += 2) {
            const bool last = (t == nt - 2);
            const char* a1 = cA + (size_t)(t + 1) * kstep;
            const char* a2 = last ? nA : cA + (size_t)(t + 2) * kstep; const char* b2 = last ? nB : cB + (size_t)(t + 2) * kstep;
            const char* a3 = a2 + kstep; const char* b3 = b2 + kstep;
            if (last && has_next) S.a_ready(nxt);
            PG8_LDB(B0, 0, 0); PG8_SCHED; PG8_LDA(At, 0, 0); PG8_STAGE(PG8_SA(1, 1), a1 + hstep, voffA);
            PG8_WAIT_L(8); PG8_BAR; PG8_WAIT_L(0); PG8_MMA(0, 0, At, B0); PG8_BAR; PG8_SCHED;
            PG8_LDB(B1, 0, 1); PG8_STAGE(PG8_SB(0, 0), b2, voffB);
            PG8_BAR; PG8_WAIT_L(0); PG8_MMA(0, 1, At, B1); PG8_BAR;
            PG8_LDA(At, 0, 1); PG8_STAGE(PG8_SA(0, 0), a2, voffA);
            PG8_BAR; PG8_WAIT_L(0); PG8_MMA(1, 0, At, B0); PG8_BAR; PG8_SCHED;
            PG8_STAGE(PG8_SB(0, 1), b2 + hstep, voffB);
            PG8_WAIT_V(6); PG8_BAR; PG8_MMA(1, 1, At, B1); PG8_BAR;
            PG8_LDB(B0, 1, 0); PG8_SCHED; PG8_LDA(At, 1, 0); PG8_STAGE(PG8_SA(0, 1), a2 + hstep, voffA);
            PG8_WAIT_L(8); PG8_BAR; PG8_WAIT_L(0); PG8_MMA(0, 0, At, B0); PG8_BAR; PG8_SCHED;
            PG8_LDB(B1, 1, 1); PG8_STAGE(PG8_SB(1, 0), b3, voffB);
            PG8_BAR; PG8_WAIT_L(0); PG8_MMA(0, 1, At, B1); PG8_BAR;
            PG8_LDA(At, 1, 1); PG8_STAGE(PG8_SA(1, 0), a3, voffA);
            PG8_BAR; PG8_WAIT_L(0); PG8_MMA(1, 0, At, B0); PG8_BAR; PG8_SCHED;
            PG8_STAGE(PG8_SB(1, 1), b3 + hstep, voffB);
            PG8_WAIT_V(6); PG8_BAR; PG8_MMA(1, 1, At, B1); PG8_BAR;
        }
        PG8_STAMP();
        if constexpr (!Epi::AFTER_DRAIN) { E(acc, cur, wr, wc, fr, fq); S.done(cur); }
        PG8_STAMP();
        if (!has_next) break;
#pragma unroll
        for (int a = 0; a < 2; ++a)
#pragma unroll
            for (int b = 0; b < 2; ++b)
#pragma unroll
                for (int m = 0; m < 4; ++m)
#pragma unroll
                    for (int n = 0; n < 2; ++n) acc[a][b][m][n] = (f32x4){0.f, 0.f, 0.f, 0.f};
        cur = nxt; cA = nA; cB = nB; ++ui;
    }
    PG8_WAIT_V(0);
    if (wr == 0) PG8_BAR;
    PG8_BAR;
    if constexpr (Epi::AFTER_DRAIN) { E.fused(acc, cur, wr, wc, fr, fq, lds, wid, lane); S.done(cur); }
    PG8_STAMP();
    if (STAMP && wid == 0) { stamps[lane] = lane < nts ? (((unsigned long long)(unsigned)ts_hi << 32) | (unsigned)ts_lo) : 0ull;
        if (lane == 62) stamps[62] = rt_entry; if (lane == 63) stamps[63] = (unsigned long long)wall_clock64(); }
#undef PG8_STAMP
#undef PG8_SA
#undef PG8_SB
#undef PG8_STAGE
#undef PG8_LDA
#undef PG8_LDB
#undef PG8_MMA
#undef PG8_WAIT_V
#undef PG8_WAIT_L
#undef PG8_BAR
#undef PG8_SCHED
}
}
#define LAS __attribute__((address_space(3)))
#define XB_TMO      128
#define XB_XCNT(j)  (256  + 64 * (j))
#define XB_XSUB(j)  (1280 + 64 * (j))
#define XB_XGEN(j)  (2304 + 64 * (j))
#define XB_TOP      3328
#define XB_TOPGEN   3392
#define XCD_BAR_WORDS 3456
#define XB_SPIN_CAP (1u << 18)


__device__ __forceinline__ unsigned xb_ld(unsigned* p)              { return __hip_atomic_load(p, __ATOMIC_RELAXED, __HIP_MEMORY_SCOPE_AGENT); }
__device__ __forceinline__ unsigned xb_add(unsigned* p, unsigned v) { return __hip_atomic_fetch_add(p, v, __ATOMIC_RELAXED, __HIP_MEMORY_SCOPE_AGENT); }
__device__ __forceinline__ unsigned xb_xcc_id() { return (unsigned)__builtin_amdgcn_s_getreg((3 << 11) | 20) & 0xFu; }
#define XB_SPIN(cond, bar) do { unsigned _sp = 0; while (cond) { __builtin_amdgcn_s_sleep(1); \
    if ((++_sp & 255u) == 0u) { if (xb_ld(&(bar)[XB_TMO])) break; if (_sp > XB_SPIN_CAP) { atomicAdd(&(bar)[XB_TMO], 1u); break; } } } } while (0)

struct XcdBarrier {
    unsigned* bar; unsigned x;
    volatile LAS unsigned* st;
};

__device__ __forceinline__ XcdBarrier xcd_barrier_post(unsigned* bar, volatile LAS unsigned* st) {
    XcdBarrier b; b.bar = bar; b.x = xb_xcc_id(); b.st = st;
    if (threadIdx.x == 0) (void)xb_add(&bar[XB_XCNT(b.x)], 1u);
    return b;
}
__device__ __forceinline__ void xcd_barrier_complete(unsigned* bar, unsigned x, unsigned& nloc, unsigned& nx) {
    const unsigned G = gridDim.x * gridDim.y * gridDim.z;
    unsigned sum, cnt, mine, sp = 0u;
    for (;;) {
        sum = 0u; cnt = 0u; mine = 0u;
#pragma unroll
        for (unsigned j = 0; j < 16; ++j) { const unsigned c = xb_ld(&bar[XB_XCNT(j)]); sum += c; cnt += (c > 0u) ? 1u : 0u; mine = (j == x) ? c : mine; }
        if (sum == G) break;
        __builtin_amdgcn_s_sleep(1);
        if ((++sp & 255u) == 0u) { if (xb_ld(&bar[XB_TMO])) break; if (sp > XB_SPIN_CAP) { atomicAdd(&bar[XB_TMO], 1u); break; } }
    }
    nloc = mine > 0u ? mine : 1u; nx = cnt > 0u ? cnt : 1u;
}

__device__ __forceinline__ void xcd_barrier(const XcdBarrier& b) {
    asm volatile("s_waitcnt vmcnt(0)" ::: "memory");
    __syncthreads();
    if (threadIdx.x == 0) {
        unsigned* bar = b.bar;
        __builtin_amdgcn_s_waitcnt(0);
        unsigned nloc = b.st[0], nx = b.st[1];
        if (nloc == 0u) { xcd_barrier_complete(bar, b.x, nloc, nx); b.st[0] = nloc; b.st[1] = nx; }
        const unsigned old = xb_add(&bar[XB_XSUB(b.x)], 1u);
        const unsigned gen = old / nloc;
        if (old + 1u == (gen + 1u) * nloc) {
            __builtin_amdgcn_fence(__ATOMIC_RELEASE, "agent");
            asm volatile("s_waitcnt vmcnt(0)" ::: "memory");
            const unsigned og = xb_add(&bar[XB_TOP], 1u);
            const unsigned tg = og / nx;
            if (og + 1u == (tg + 1u) * nx) xb_add(&bar[XB_TOPGEN], 1u);
            else XB_SPIN(xb_ld(&bar[XB_TOPGEN]) == tg, bar);
            __builtin_amdgcn_fence(__ATOMIC_ACQUIRE, "agent");
            xb_add(&bar[XB_XGEN(b.x)], 1u);
            asm volatile("s_waitcnt vmcnt(0)" ::: "memory");
        } else {
            XB_SPIN(xb_ld(&bar[XB_XGEN(b.x)]) == gen, bar);
            __builtin_amdgcn_fence(__ATOMIC_ACQUIRE, "agent");
            asm volatile("s_waitcnt vmcnt(0)" ::: "memory");
        }
    }
    __syncthreads();
}

using pg8::bf16_t; using pg8::bf16x8; using pg8::f32x4; using pg8::u32x4; using pg8::Unit; using pg8::BM; using pg8::HALF;
typedef float f32x2 __attribute__((ext_vector_type(2)));
typedef unsigned u32x2 __attribute__((ext_vector_type(2)));
typedef _Float16 f16x4 __attribute__((ext_vector_type(4)));

constexpr int D = 1024, FF = 2816, NIN = 1536, GWID = 512, DEPTH = 4;
constexpr int SEQ = 2048, NB = 8, MP = NB * SEQ, MS = 128, MV = MP + MS, MPAD = 16640;
constexpr int NTHR = 512, NWAVES = 8;
constexpr int LDS_STAGE = 131072, LDS_BYTES = LDS_STAGE + 16;
constexpr float LN_EPS = 1e-5f;
constexpr float ALPHA = 1.6817928305074292f;

constexpr size_t W_GU1 = 0, W_D1 = W_GU1 + (size_t)2 * FF * D, W_IN = W_D1 + (size_t)FF * D, W_OUT = W_IN + (size_t)NIN * D,
                 W_GU2 = W_OUT + (size_t)D * D, W_D2 = W_GU2 + (size_t)2 * FF * D, W_LAYER = W_D2 + (size_t)FF * D;
constexpr size_t WS_W = 0;
constexpr size_t WS_SMALL = WS_W + W_LAYER * 2 * DEPTH;
constexpr size_t SMALL_LAYER = 32768 * 2 + 65536;
constexpr size_t WS_X = WS_SMALL + SMALL_LAYER * 2 * DEPTH;
constexpr size_t WS_XN = WS_X + (size_t)MPAD * D * 4;
constexpr size_t WS_HP = WS_XN + (size_t)MPAD * D * 2;
constexpr size_t WS_MIX = WS_HP + (size_t)MPAD * NIN * 4;
constexpr size_t WS_AGG = WS_MIX + (size_t)MPAD * D * 2;
constexpr size_t WS_BAR = WS_AGG + (size_t)NB * 32 * 2 * 512 * 4;
constexpr size_t WS_PART = WS_BAR + 16384;
constexpr size_t WS_END = WS_PART + (size_t)4 * MS * D * 4;
static_assert((size_t)MPAD * FF * 2 <= (size_t)MPAD * NIN * 4, "hid fits in the proj region");
static_assert(WS_END <= 408000000ull, "workspace budget");

constexpr size_t O_Y = 0, O_PH = (size_t)MV * D, O_PC = O_PH + (size_t)DEPTH * NB * GWID, O_PP = O_PC + (size_t)DEPTH * NB * 3 * GWID,
                 O_SH = O_PP + (size_t)DEPTH * NB * 15 * GWID, O_SC = O_SH + (size_t)DEPTH * MS * GWID, O_SP = O_SC + (size_t)DEPTH * MS * 3 * GWID;

struct Params { const float* in[24]; float* out; unsigned char* ws; };
typedef const Params __attribute__((address_space(4))) CParams;
enum { I_XP = 0, I_XS, I_SH, I_SC, I_SP, I_LNG, I_LNB, I_W1G, I_W1U, I_W1D, I_WIN, I_CW, I_CB, I_GAW, I_GAB, I_GXW, I_GXB, I_LAM, I_PW, I_PS, I_WOUT, I_W2G, I_W2U, I_W2D };

__device__ __forceinline__ unsigned pk2(float lo, float hi) { return pg8::cvt_pk_bf16(lo, hi); }
__device__ __forceinline__ bf16_t f2bf(float f) { return (bf16_t)(pg8::cvt_pk_bf16(f, 0.f) & 0xffffu); }
__device__ __forceinline__ float wave_sum(float v) {
#pragma unroll
    for (int o = 1; o < 64; o <<= 1) v += __shfl_xor(v, o);
    return v;
}
__device__ __forceinline__ float sigmoidf_(float x) { return __builtin_amdgcn_rcpf(1.0f + __expf(-x)); }
__device__ __forceinline__ float gelu_tanh(float x) {
    const float z = 0.7978845608028654f * (x + 0.044715f * x * x * x);
    const float e = __expf(2.0f * z);
    const float th = 1.0f - 2.0f * __builtin_amdgcn_rcpf(e + 1.0f);
    return 0.5f * x * (1.0f + th);
}

struct EpiSwiglu {
    static constexpr bool PERM = true, AFTER_DRAIN = false;
    bf16_t* O; int ldc;
    __device__ __forceinline__ void operator()(const f32x4 (&acc)[2][2][4][2], const Unit& u, int wr, int wc, int fr, int fq) const {
        const int row0 = u.pm * BM + wr * 64 + fr, col0 = u.pn * 128 + wc * 32 + 8 * fq;
#pragma unroll
        for (int ai = 0; ai < 2; ++ai)
#pragma unroll
            for (int m = 0; m < 4; ++m) {
                bf16_t* rowp = O + (size_t)(row0 + ai * HALF + m * 16) * ldc + col0;
                float h[8];
#pragma unroll
                for (int n = 0; n < 2; ++n)
#pragma unroll
                    for (int j = 0; j < 4; ++j) { const float g = acc[ai][0][m][n][j], up = acc[ai][1][m][n][j]; h[n * 4 + j] = g * __builtin_amdgcn_rcpf(1.0f + __expf(-g)) * up; }
                u32x4 w; w.x = pk2(h[0], h[1]); w.y = pk2(h[2], h[3]); w.z = pk2(h[4], h[5]); w.w = pk2(h[6], h[7]);
                *(u32x4*)rowp = w;
            }
    }
};
struct EpiResid {
    static constexpr bool PERM = false, AFTER_DRAIN = false;
    float* X; int ldc; float alpha, coef;
    __device__ __forceinline__ void operator()(const f32x4 (&acc)[2][2][4][2], const Unit& u, int wr, int wc, int fr, int fq) const {
        const int row0 = u.pm * BM + wr * 64 + fr, col0 = u.pn * BM + wc * 32 + 4 * fq;
#pragma unroll
        for (int ai = 0; ai < 2; ++ai)
#pragma unroll
            for (int m = 0; m < 4; ++m) { float* rowp = X + (size_t)(row0 + ai * HALF + m * 16) * ldc + col0;
#pragma unroll
                for (int bj = 0; bj < 2; ++bj)
#pragma unroll
                    for (int n = 0; n < 2; ++n) { f32x4* p = (f32x4*)(rowp + bj * HALF + n * 16); const f32x4 v = *p; *p = v * alpha + acc[ai][bj][m][n] * coef; } }
    }
};

__device__ __forceinline__ void transpose_item(const float* W, int K, int N, bf16_t* WT, int mode, LAS float* scr, int item, int lane) {
    const int nblk = N / 32, kb = item / nblk, nb = item % nblk, k0 = 64 * kb, n0 = 32 * nb;
    const int drow0 = mode == 0 ? n0 : (256 * (n0 >> 7) + (n0 & 127) + (mode == 2 ? 128 : 0));
#pragma unroll
    for (int i = 0; i < 32; ++i) { const int kk = 2 * i + (lane >> 5); scr[kk * 33 + (lane & 31)] = W[(size_t)(k0 + kk) * N + n0 + (lane & 31)]; }
    asm volatile("s_waitcnt lgkmcnt(0)" ::: "memory");
    const int c = lane & 7;
#pragma unroll
    for (int j = 0; j < 4; ++j) { const int n = (lane >> 3) + 8 * j; const LAS float* s = scr + (8 * c) * 33 + n;
        u32x4 o; o.x = pk2(s[0 * 33], s[1 * 33]); o.y = pk2(s[2 * 33], s[3 * 33]); o.z = pk2(s[4 * 33], s[5 * 33]); o.w = pk2(s[6 * 33], s[7 * 33]);
        *(u32x4*)(WT + (size_t)(drow0 + n) * K + k0 + 8 * c) = o; }
    asm volatile("s_waitcnt lgkmcnt(0)" ::: "memory");
}
__device__ __forceinline__ void prologue(CParams* P, LAS unsigned char* lds, int gw, int NGW, int wave, int lane) {
    LAS float* scr = (LAS float*)(lds + wave * 16384);
    bf16_t* Wb = (bf16_t*)(P->ws + WS_W);
    constexpr int I_G = (D / 64) * (FF / 32), I_DN = (FF / 64) * (D / 32), I_I = (D / 64) * (NIN / 32), I_O = (D / 64) * (D / 32);
    constexpr int PER_LAYER = 4 * I_G + 2 * I_DN + I_I + I_O;
    for (int it = gw; it < PER_LAYER * DEPTH; it += NGW) {
        const int l = it / PER_LAYER; int r = it % PER_LAYER; bf16_t* WL = Wb + (size_t)l * W_LAYER;
        if (r < I_G) { transpose_item(P->in[I_W1G] + (size_t)l * D * FF, D, FF, WL + W_GU1, 1, scr, r, lane); continue; } r -= I_G;
        if (r < I_G) { transpose_item(P->in[I_W1U] + (size_t)l * D * FF, D, FF, WL + W_GU1, 2, scr, r, lane); continue; } r -= I_G;
        if (r < I_DN) { transpose_item(P->in[I_W1D] + (size_t)l * D * FF, FF, D, WL + W_D1, 0, scr, r, lane); continue; } r -= I_DN;
        if (r < I_I) { transpose_item(P->in[I_WIN] + (size_t)l * D * NIN, D, NIN, WL + W_IN, 0, scr, r, lane); continue; } r -= I_I;
        if (r < I_O) { transpose_item(P->in[I_WOUT] + (size_t)l * D * D, D, D, WL + W_OUT, 0, scr, r, lane); continue; } r -= I_O;
        if (r < I_G) { transpose_item(P->in[I_W2G] + (size_t)l * D * FF, D, FF, WL + W_GU2, 1, scr, r, lane); continue; } r -= I_G;
        if (r < I_G) { transpose_item(P->in[I_W2U] + (size_t)l * D * FF, D, FF, WL + W_GU2, 2, scr, r, lane); continue; } r -= I_G;
        transpose_item(P->in[I_W2D] + (size_t)l * D * FF, FF, D, WL + W_D2, 0, scr, r, lane);
    }
    bf16_t* Sm = (bf16_t*)(P->ws + WS_SMALL);
    const int gt = gw * 64 + lane, NGT = NGW * 64;
    for (int o = gt; o < DEPTH * 32768; o += NGT) {
        const int l = o / 32768, rem = o % 32768, h = rem / 4096, j = (rem / 64) % 64, i = rem % 64;
        const size_t src = (size_t)l * 32768 + h * 4096 + i * 64 + j;
        Sm[(size_t)l * SMALL_LAYER + rem] = f2bf(P->in[I_GAW][src]);
        Sm[(size_t)l * SMALL_LAYER + 32768 + rem] = f2bf(P->in[I_GXW][src]);
    }
    for (int o = gt; o < DEPTH * 65536; o += NGT) {
        const int l = o / 65536, rem = o % 65536, g = rem / 16384, j = (rem / 128) % 128, i = rem % 128;
        Sm[(size_t)l * SMALL_LAYER + 65536 + rem] = f2bf(P->in[I_PW][(size_t)l * 65536 + g * 16384 + i * 128 + j]);
    }
    for (int o = gt; o < DEPTH * MS * 2 * (GWID / 4); o += NGT) { const int c4 = o % (GWID / 4), k = (o / (GWID / 4)) % 2, lb = o / (2 * (GWID / 4));
        *(f32x4*)(P->out + O_SC + ((size_t)lb * 3 + k) * GWID + 4 * c4) = *(const f32x4*)(P->in[I_SC] + ((size_t)lb * 3 + k + 1) * GWID + 4 * c4); }
    for (int o = gt; o < DEPTH * MS * 14 * (GWID / 4); o += NGT) { const int c4 = o % (GWID / 4), k = (o / (GWID / 4)) % 14, lb = o / (14 * (GWID / 4));
        *(f32x4*)(P->out + O_SP + ((size_t)lb * 15 + k) * GWID + 4 * c4) = *(const f32x4*)(P->in[I_SP] + ((size_t)lb * 15 + k + 1) * GWID + 4 * c4); }
    float* X = (float*)(P->ws + WS_X); bf16_t* XN = (bf16_t*)(P->ws + WS_XN);
    for (int m = gw; m < MV; m += NGW) {
        const float* src = m < MP ? P->in[I_XP] + (size_t)m * D : P->in[I_XS] + (size_t)(m - MP) * D;
        const f32x4* xr = (const f32x4*)src + lane; f32x4* xo = (f32x4*)(X + (size_t)m * D) + lane; u32x2* o8 = (u32x2*)(XN + (size_t)m * D) + lane;
#pragma unroll
        for (int j = 0; j < 4; ++j) { const f32x4 v = xr[64 * j]; xo[64 * j] = v; u32x2 w; w.x = pk2(v[0], v[1]); w.y = pk2(v[2], v[3]); o8[64 * j] = w; }
    }
}

__device__ __forceinline__ void sample_skinny(const bf16_t* A  , const bf16_t* Bt  , int K, float* part, int bid, int wave, int fr, int fq) {
    if (bid >= 256) return;
    const int cb = bid & 63, ks = bid >> 6, Ks = K >> 2, n0 = 16 * cb;
    const bf16_t* ap = A + (size_t)(16 * wave + fr) * K + ks * Ks + 8 * fq;
    const bf16_t* bp = Bt + (size_t)(n0 + fr) * K + ks * Ks + 8 * fq;
    f32x4 acc = (f32x4){0.f, 0.f, 0.f, 0.f};
    const int nk = Ks >> 5;
    int kb = 0;
    for (; kb + 8 <= nk; kb += 8) {
        bf16x8 a[8], bb[8];
#pragma unroll
        for (int i = 0; i < 8; ++i) { a[i] = *(const bf16x8*)(ap + (kb + i) * 32); bb[i] = *(const bf16x8*)(bp + (kb + i) * 32); }
#pragma unroll
        for (int i = 0; i < 8; ++i) acc = __builtin_amdgcn_mfma_f32_16x16x32_bf16(bb[i], a[i], acc, 0, 0, 0);
    }
    for (; kb < nk; ++kb) { const bf16x8 a = *(const bf16x8*)(ap + kb * 32), bb = *(const bf16x8*)(bp + kb * 32); acc = __builtin_amdgcn_mfma_f32_16x16x32_bf16(bb, a, acc, 0, 0, 0); }
    *(f32x4*)(part + ((size_t)ks * MS + 16 * wave + fr) * D + n0 + 4 * fq) = acc;
}

__device__ __forceinline__ void ln_pass(float* X, bf16_t* XN, float* OUT, const float* g, const float* b, const float* part, float coef, int gw, int NGW, int lane) {
    f32x4 gg[4], bb[4];
#pragma unroll
    for (int j = 0; j < 4; ++j) { gg[j] = ((const f32x4*)g)[lane + 64 * j]; bb[j] = ((const f32x4*)b)[lane + 64 * j]; }
    for (int m = gw; m < MV; m += NGW) {
        const f32x4* xr = (const f32x4*)(X + (size_t)m * D) + lane;
        f32x4 v[4]; float s = 0.f;
#pragma unroll
        for (int j = 0; j < 4; ++j) v[j] = xr[64 * j];
        if (m >= MP) {
#pragma unroll
            for (int j = 0; j < 4; ++j) { f32x4 a = (f32x4){0.f, 0.f, 0.f, 0.f};
#pragma unroll
                for (int ks = 0; ks < 4; ++ks) a += ((const f32x4*)(part + ((size_t)ks * MS + (m - MP)) * D) + lane)[64 * j];
                v[j] = v[j] * ALPHA + a * coef; }
        }
#pragma unroll
        for (int j = 0; j < 4; ++j) s += (v[j][0] + v[j][1]) + (v[j][2] + v[j][3]);
        const float mean = wave_sum(s) * (1.f / D); float s2 = 0.f;
#pragma unroll
        for (int j = 0; j < 4; ++j) { v[j] = v[j] - mean; s2 += (v[j][0] * v[j][0] + v[j][1] * v[j][1]) + (v[j][2] * v[j][2] + v[j][3] * v[j][3]); }
        const float rstd = 1.0f / sqrtf(wave_sum(s2) * (1.f / D) + LN_EPS);
        f32x4* xo = (f32x4*)((OUT ? OUT : X) + (size_t)m * D) + lane; u32x2* o8 = (u32x2*)(XN + (size_t)m * D) + lane;
#pragma unroll
        for (int j = 0; j < 4; ++j) { const f32x4 y = v[j] * rstd * gg[j] + bb[j]; xo[64 * j] = y; u32x2 w; w.x = pk2(y[0], y[1]); w.y = pk2(y[2], y[3]); o8[64 * j] = w; }
    }
}

constexpr int XCS = 520;
constexpr int XC_OFF = 0, R_OFF = 32 * XCS * 2, I_OFF = 2 * 32 * XCS * 2;

template <int NMB>
__device__ __forceinline__ void gates_mfma(LAS unsigned char* lds, const bf16_t* WaT, const bf16_t* WxT, const float* ba, const float* bx, int h, int fr, int fq) {
    bf16x8 A[NMB][2];
#pragma unroll
    for (int mb = 0; mb < NMB; ++mb)
#pragma unroll
        for (int kb = 0; kb < 2; ++kb) A[mb][kb] = *(const LAS bf16x8*)(lds + XC_OFF + ((mb * 16 + fr) * XCS + 64 * h + kb * 32 + 8 * fq) * 2);
#pragma unroll
    for (int gate = 0; gate < 2; ++gate) {
        const bf16_t* W = (gate ? WxT : WaT) + h * 4096; const float* bias = (gate ? bx : ba) + 64 * h; const int ooff = gate ? I_OFF : R_OFF;
#pragma unroll
        for (int nb = 0; nb < 4; ++nb) {
            const bf16x8 B0 = *(const bf16x8*)(W + (nb * 16 + fr) * 64 + 8 * fq), B1 = *(const bf16x8*)(W + (nb * 16 + fr) * 64 + 32 + 8 * fq);
            const f32x4 bv = *(const f32x4*)(bias + nb * 16 + 4 * fq);
#pragma unroll
            for (int mb = 0; mb < NMB; ++mb) {
                f32x4 acc = (f32x4){0.f, 0.f, 0.f, 0.f};
                acc = __builtin_amdgcn_mfma_f32_16x16x32_bf16(B0, A[mb][0], acc, 0, 0, 0);
                acc = __builtin_amdgcn_mfma_f32_16x16x32_bf16(B1, A[mb][1], acc, 0, 0, 0);
                acc = acc + bv;
                f16x4 hv; hv[0] = (_Float16)sigmoidf_(acc[0]); hv[1] = (_Float16)sigmoidf_(acc[1]); hv[2] = (_Float16)sigmoidf_(acc[2]); hv[3] = (_Float16)sigmoidf_(acc[3]);
                *(LAS f16x4*)(lds + ooff + ((mb * 16 + fr) * XCS + 64 * h + nb * 16 + 4 * fq) * 2) = hv;
            }
        }
    }
}
template <int NMB>
__device__ __forceinline__ void pool_mfma(LAS unsigned char* lds, const bf16_t* PWT, const float* pscale, bf16_t* mixrow, int w, int fr, int fq) {
    const int g = w >> 1, half = w & 1;
    f32x4 acc[NMB][4];
#pragma unroll
    for (int mb = 0; mb < NMB; ++mb)
#pragma unroll
        for (int nb = 0; nb < 4; ++nb) acc[mb][nb] = (f32x4){0.f, 0.f, 0.f, 0.f};
#pragma unroll
    for (int kb = 0; kb < 4; ++kb) {
        bf16x8 A[NMB];
#pragma unroll
        for (int mb = 0; mb < NMB; ++mb) A[mb] = *(const LAS bf16x8*)(lds + ((mb * 16 + fr) * XCS + 128 * g + kb * 32 + 8 * fq) * 2);
#pragma unroll
        for (int nb = 0; nb < 4; ++nb) {
            const bf16x8 B = *(const bf16x8*)(PWT + ((size_t)g * 128 + 64 * half + nb * 16 + fr) * 128 + kb * 32 + 8 * fq);
#pragma unroll
            for (int mb = 0; mb < NMB; ++mb) acc[mb][nb] = __builtin_amdgcn_mfma_f32_16x16x32_bf16(B, A[mb], acc[mb][nb], 0, 0, 0);
        }
    }
#pragma unroll
    for (int nb = 0; nb < 4; ++nb) {
        const int ch = 128 * g + 64 * half + nb * 16 + 4 * fq; const f32x4 sc = *(const f32x4*)(pscale + ch);
#pragma unroll
        for (int mb = 0; mb < NMB; ++mb) { const f32x4 v = acc[mb][nb] * sc; u32x2 o; o.x = pk2(v[0], v[1]); o.y = pk2(v[2], v[3]);
            *(u32x2*)(mixrow + (size_t)(mb * 16 + fr) * D + GWID + ch) = o; }
    }
}
template <int W>
__device__ __forceinline__ void pool_prompt_thread(const float* UP, int t0, LAS bf16_t* PL, int c) {
    float hist[W - 1], v[64]; float s = 0.f;
#pragma unroll
    for (int k = 0; k < W - 1; ++k) hist[k] = (t0 > 0) ? (UP + (k - (W - 1)) * NIN)[c] : 0.f;
#pragma unroll
    for (int t = 0; t < 64; ++t) v[t] = (UP + t * NIN)[c];
#pragma unroll
    for (int k = 0; k < W - 1; ++k) s += hist[k];
#pragma unroll
    for (int t = 0; t < 64; ++t) {
        s += v[t];
        const float rc = (t >= W - 1 || t0 > 0) ? (1.0f / (float)W) : (1.0f / (float)(t + 1));
        PL[t * XCS + c] = f2bf(s * rc - v[t]);
        s -= (t - W + 1 >= 0) ? v[t - W + 1 >= 0 ? t - W + 1 : 0] : hist[t < W - 1 ? t : 0];
    }
}
template <int W>
__device__ __forceinline__ void pool_sample_thread(const float* UP, const float* SPs, float* SPo, LAS bf16_t* PL, int c) {
    float v[16];
#pragma unroll
    for (int t = 0; t < 16; ++t) v[t] = (UP + (size_t)t * NIN)[c];
#pragma unroll
    for (int t0 = 0; t0 < 16; t0 += 4) {
        float q[4][W - 1];
#pragma unroll
        for (int t = 0; t < 4; ++t)
#pragma unroll
            for (int k = 0; k < W - 1; ++k) q[t][k] = (SPs + ((size_t)(t0 + t) * 15 + (16 - W) + k) * GWID)[c];
#pragma unroll
        for (int t = 0; t < 4; ++t) { float s = v[t0 + t];
#pragma unroll
            for (int k = 0; k < W - 1; ++k) s += q[t][k];
            PL[(t0 + t) * XCS + c] = f2bf(s * (1.0f / (float)W) - v[t0 + t]); }
    }
#pragma unroll
    for (int t = 0; t < 16; ++t) (SPo + ((size_t)t * 15 + 14) * GWID)[c] = v[t];
}
#define LDS_SYNC() asm volatile("s_waitcnt lgkmcnt(0)\n\ts_barrier" ::: "memory")
template <int S>
__device__ __forceinline__ void lru_scan_sub(LAS unsigned char* lds, const float (&xc)[32], float k8, float& h, float& cum, float (&hloc)[64], float (&cumA)[64], int c) {
#pragma unroll
    for (int t = 0; t < 32; ++t) {
        const float r = (float)((const LAS _Float16*)(lds + R_OFF))[t * XCS + c], ig = (float)((const LAS _Float16*)(lds + I_OFF))[t * XCS + c];
        const float la = r * k8, a = __expf(la), mult = __builtin_amdgcn_sqrtf(fmaxf(1.0f - a * a, 0.0f)), uu = mult * (ig * xc[t]);
        h = a * h + uu; cum *= a; hloc[S * 32 + t] = h; cumA[S * 32 + t] = cum;
    }
}

struct MixW {
    const float *cw, *cb, *gab, *gxb, *lam, *psc; const bf16_t *GAT, *GXT, *PWT;
};

__global__ void __launch_bounds__(NTHR, 2) fwd_megakernel(Params p) {
    extern __shared__ __attribute__((aligned(16))) unsigned char lds_raw[];
    LAS unsigned char* lds = (LAS unsigned char*)lds_raw;
    cg::grid_group grid = cg::this_grid();
    const int G0 = gridDim.x, bid0 = blockIdx.x;

#ifdef TIME_CLASS
    const unsigned long long t_pro0 = __builtin_amdgcn_s_memrealtime();
#endif
    if (threadIdx.x == 0) { ((LAS unsigned*)(lds + LDS_STAGE))[0] = 0u; ((LAS unsigned*)(lds + LDS_STAGE))[1] = 0u; }
    __syncthreads();
    (void)xcd_barrier_post((unsigned*)(((CParams*)__builtin_amdgcn_kernarg_segment_ptr())->ws + WS_BAR), (volatile LAS unsigned*)(lds + LDS_STAGE));
#define GSYNC() do { XcdBarrier b_; b_.bar = (unsigned*)(ws + WS_BAR); b_.x = xb_xcc_id(); b_.st = (volatile LAS unsigned*)(lds + LDS_STAGE); xcd_barrier(b_); } while (0)
    { const int tid = threadIdx.x, lane = tid & 63, wave = __builtin_amdgcn_readfirstlane(tid >> 6);
      prologue((CParams*)__builtin_amdgcn_kernarg_segment_ptr(), lds, bid0 * NWAVES + wave, G0 * NWAVES, wave, lane); }
    if (G0 == 0x7fffffff) grid.sync();
    { unsigned char* const ws = ((CParams*)__builtin_amdgcn_kernarg_segment_ptr())->ws; GSYNC(); }

    constexpr int NK = 10;
#ifdef TIME_CLASS
    unsigned long long t_acc = (TIME_CLASS == 5) ? (__builtin_amdgcn_s_memrealtime() - t_pro0) : 0ull;
#endif
    for (int ph = 0; ph < DEPTH * NK; ++ph) {
        const int l = ph / NK, kind = ph % NK;
#ifdef TIME_CLASS
        const unsigned long long t_beg = __builtin_amdgcn_s_memrealtime();
#endif
        int G = G0, bid = bid0; asm volatile("" : "+s"(G), "+s"(bid));
        const int NGW = G * NWAVES;
        int tid = threadIdx.x; asm volatile("" : "+v"(tid));
        const int lane = tid & 63, wave = __builtin_amdgcn_readfirstlane(tid >> 6), fr = lane & 15, fq = lane >> 4, gw = bid * NWAVES + wave;
        CParams* P = (CParams*)__builtin_amdgcn_kernarg_segment_ptr(); asm volatile("" : "+s"(P));
        unsigned char* const ws = P->ws;
        float* X = (float*)(ws + WS_X); bf16_t* XN = (bf16_t*)(ws + WS_XN); bf16_t* HID = (bf16_t*)(ws + WS_HP); float* PROJ = (float*)(ws + WS_HP);
        bf16_t* MIX = (bf16_t*)(ws + WS_MIX); float* AGG = (float*)(ws + WS_AGG);
        const bf16_t* Wb = (const bf16_t*)(ws + WS_W); const bf16_t* Sm = (const bf16_t*)(ws + WS_SMALL);
        const bf16_t* WL = Wb + (size_t)l * W_LAYER;
        if (kind == 0 || kind == 7) {
            pg8::Gemm g{XN, WL + (kind == 0 ? W_GU1 : W_GU2), MPAD, 2 * FF, D}; pg8::StaticOrder S; S.init(MPAD, 2 * FF, G, bid);
            EpiSwiglu E{HID, FF};
            pg8::gemm_phase<EpiSwiglu, pg8::StaticOrder>(lds, g, S, E, nullptr);
        } else if (kind == 1 || kind == 8 || kind == 5) {
            const bool wo = (kind == 5);
            const bf16_t* Bw = WL + (wo ? W_OUT : (kind == 1 ? W_D1 : W_D2)); const int Kd = wo ? D : FF;
            sample_skinny((wo ? MIX : HID) + (size_t)MP * Kd, Bw, Kd, (float*)(ws + WS_PART), bid, wave, fr, fq);
            pg8::Gemm g{wo ? MIX : HID, Bw, MP, D, Kd}; pg8::StaticOrder S; S.init(MP, D, G, bid);
            EpiResid E{X, D, ALPHA, wo ? 1.0f : 0.5f};
            pg8::gemm_phase<EpiResid, pg8::StaticOrder>(lds, g, S, E, nullptr);
        } else if (kind == 3) {
            pg8::Gemm g{XN, WL + W_IN, MPAD, NIN, D}; pg8::StaticOrder S; S.init(MPAD, NIN, G, bid);
            pg8::EpiF32 E{PROJ, NIN, nullptr};
            pg8::gemm_phase<pg8::EpiF32, pg8::StaticOrder>(lds, g, S, E, nullptr);
        } else if (kind == 2 || kind == 6 || kind == 9) {
            const int which = kind == 2 ? 0 : (kind == 6 ? 1 : 2);
            const bool fin = (l == DEPTH - 1 && which == 2);
            ln_pass(X, XN, fin ? P->out + O_Y : nullptr, P->in[I_LNG] + (size_t)(l * 3 + which) * D, P->in[I_LNB] + (size_t)(l * 3 + which) * D, (const float*)(ws + WS_PART), which == 1 ? 1.0f : 0.5f, gw, NGW, lane);
        } else {
            MixW mw; mw.cw = P->in[I_CW] + (size_t)l * 4 * GWID; mw.cb = P->in[I_CB] + (size_t)l * GWID; mw.gab = P->in[I_GAB] + (size_t)l * GWID; mw.gxb = P->in[I_GXB] + (size_t)l * GWID;
            mw.lam = P->in[I_LAM] + (size_t)l * GWID; mw.psc = P->in[I_PS] + (size_t)l * GWID;
            mw.GAT = Sm + (size_t)l * SMALL_LAYER; mw.GXT = mw.GAT + 32768; mw.PWT = mw.GAT + 65536;
            const int c = tid;
            const bool has = bid < NB * 32;
            const int b = bid >> 5, j = bid & 31, t0 = j * 64; const size_t row0 = (size_t)b * SEQ + t0;
            const float cw0 = mw.cw[c], cw1 = mw.cw[GWID + c], cw2 = mw.cw[2 * GWID + c], cw3 = mw.cw[3 * GWID + c], cbv = mw.cb[c];
            const float lamv = mw.lam[c]; const float k8 = -8.0f * log1pf(__expf(-lamv));
            float hloc[64], cumA[64];
#pragma unroll
            for (int t = 0; t < 64; ++t) { hloc[t] = 0.f; cumA[t] = 0.f; }
            if (has) {
                const float* U = PROJ + row0 * NIN;
                float p0 = 0.f, p1 = 0.f, p2 = 0.f;
                if (j > 0) { p0 = (U - 3 * NIN)[c]; p1 = (U - 2 * NIN)[c]; p2 = (U - 1 * NIN)[c]; }
                {
                    const float* UP = U + 2 * GWID; LAS bf16_t* PL = (LAS bf16_t*)lds;
                    const int grp = wave >> 1;
                    if (grp == 0) pool_prompt_thread<2>(UP, t0, PL, c); else if (grp == 1) pool_prompt_thread<4>(UP, t0, PL, c);
                    else if (grp == 2) pool_prompt_thread<8>(UP, t0, PL, c); else pool_prompt_thread<16>(UP, t0, PL, c);
                    if (j == 31) { float* o = P->out + O_PP + ((size_t)(l * NB + b) * 15) * GWID; float q[15];
#pragma unroll
                        for (int k = 0; k < 15; ++k) q[k] = (UP + (49 + k) * NIN)[c];
#pragma unroll
                        for (int k = 0; k < 15; ++k) (o + k * GWID)[c] = q[k]; }
                    LDS_SYNC();
                    pool_mfma<4>(lds, mw.PWT, mw.psc, MIX + row0 * D, wave, fr, fq);
                    LDS_SYNC();
                }
                float h = 0.f, cum = 1.f;
                {
                    float xc[32], ua[32];
#pragma unroll
                    for (int t = 0; t < 32; ++t) ua[t] = (U + t * NIN)[c];
#pragma unroll
                    for (int t = 0; t < 32; ++t) { const float v = ua[t]; xc[t] = cbv + cw0 * p0 + cw1 * p1 + cw2 * p2 + cw3 * v; p0 = p1; p1 = p2; p2 = v;
                        ((LAS bf16_t*)(lds + XC_OFF))[t * XCS + c] = f2bf(xc[t]); }
                    float ub[32];
#pragma unroll
                    for (int t = 0; t < 32; ++t) ub[t] = (U + (32 + t) * NIN)[c];
                    LDS_SYNC();
                    gates_mfma<2>(lds, mw.GAT, mw.GXT, mw.gab, mw.gxb, wave, fr, fq);
                    LDS_SYNC();
                    lru_scan_sub<0>(lds, xc, k8, h, cum, hloc, cumA, c);
                    LDS_SYNC();
#pragma unroll
                    for (int t = 0; t < 32; ++t) { const float v = ub[t]; xc[t] = cbv + cw0 * p0 + cw1 * p1 + cw2 * p2 + cw3 * v; p0 = p1; p1 = p2; p2 = v;
                        ((LAS bf16_t*)(lds + XC_OFF))[t * XCS + c] = f2bf(xc[t]); }
                    LDS_SYNC();
                    gates_mfma<2>(lds, mw.GAT, mw.GXT, mw.gab, mw.gxb, wave, fr, fq);
                    LDS_SYNC();
                    lru_scan_sub<1>(lds, xc, k8, h, cum, hloc, cumA, c);
                }
                (AGG + ((size_t)(b * 32 + j) * 2 + 0) * GWID)[c] = cum; (AGG + ((size_t)(b * 32 + j) * 2 + 1) * GWID)[c] = h;
                if (j == 31) { float* o = P->out + O_PC + ((size_t)(l * NB + b) * 3) * GWID; o[c] = p0; (o + GWID)[c] = p1; (o + 2 * GWID)[c] = p2; }
            }
            GSYNC();
            if (has) {
                const float* UG = PROJ + row0 * NIN + GWID; bf16_t* mo = MIX + row0 * D;
                float g0[32], g1[32];
#pragma unroll
                for (int t = 0; t < 32; ++t) g0[t] = (UG + t * NIN)[c];
                float carry = 0.f;
#pragma unroll 16
                for (int i = 0; i < j; ++i) { const float A_ = (AGG + ((size_t)(b * 32 + i) * 2 + 0) * GWID)[c], H_ = (AGG + ((size_t)(b * 32 + i) * 2 + 1) * GWID)[c]; carry = A_ * carry + H_; }
#pragma unroll
                for (int t = 0; t < 32; ++t) g1[t] = (UG + (32 + t) * NIN)[c];
#pragma unroll
                for (int t = 0; t < 32; ++t) (mo + (size_t)t * D)[c] = f2bf((hloc[t] + cumA[t] * carry) * gelu_tanh(g0[t]));
#pragma unroll
                for (int t = 0; t < 32; ++t) (mo + (size_t)(32 + t) * D)[c] = f2bf((hloc[32 + t] + cumA[32 + t] * carry) * gelu_tanh(g1[t]));
                if (j == 31) (P->out + O_PH + (size_t)(l * NB + b) * GWID)[c] = hloc[63] + cumA[63] * carry;
            }
            if (bid >= G - 8) {
                const int b0 = (bid - (G - 8)) * 16; const size_t srow0 = (size_t)MP + b0;
                __syncthreads();
                float u[16], h0[16], gt[16];
#pragma unroll
                for (int t = 0; t < 16; ++t) { u[t] = (PROJ + (srow0 + t) * NIN)[c]; h0[t] = (P->in[I_SH] + (size_t)(l * MS + b0 + t) * GWID)[c]; gt[t] = (PROJ + (srow0 + t) * NIN + GWID)[c]; }
                {
                    const float* UP = PROJ + srow0 * NIN + 2 * GWID; LAS bf16_t* PL = (LAS bf16_t*)lds;
                    const float* SPs = P->in[I_SP] + ((size_t)(l * MS + b0) * 15) * GWID; float* SPo = P->out + O_SP + ((size_t)(l * MS + b0) * 15) * GWID;
                    const int grp = wave >> 1;
                    if (grp == 0) pool_sample_thread<2>(UP, SPs, SPo, PL, c); else if (grp == 1) pool_sample_thread<4>(UP, SPs, SPo, PL, c);
                    else if (grp == 2) pool_sample_thread<8>(UP, SPs, SPo, PL, c); else pool_sample_thread<16>(UP, SPs, SPo, PL, c);
                    LDS_SYNC();
                    pool_mfma<1>(lds, mw.PWT, mw.psc, MIX + srow0 * D, wave, fr, fq);
                    LDS_SYNC();
                }
                {
                    float xc[16];
#pragma unroll
                    for (int t = 0; t < 16; ++t) xc[t] = cbv;
#pragma unroll
                    for (int k = 0; k < 3; ++k) { float sk[16]; const float wk = k == 0 ? cw0 : (k == 1 ? cw1 : cw2);
#pragma unroll
                        for (int t = 0; t < 16; ++t) sk[t] = (P->in[I_SC] + ((size_t)(l * MS + b0 + t) * 3 + k) * GWID)[c];
#pragma unroll
                        for (int t = 0; t < 16; ++t) xc[t] += wk * sk[t]; }
#pragma unroll
                    for (int t = 0; t < 16; ++t) { xc[t] += cw3 * u[t]; ((LAS bf16_t*)(lds + XC_OFF))[t * XCS + c] = f2bf(xc[t]); }
#pragma unroll
                    for (int t = 0; t < 16; ++t) (P->out + O_SC + ((size_t)(l * MS + b0 + t) * 3 + 2) * GWID)[c] = u[t];
                    LDS_SYNC();
                    gates_mfma<1>(lds, mw.GAT, mw.GXT, mw.gab, mw.gxb, wave, fr, fq);
                    LDS_SYNC();
#pragma unroll
                    for (int t = 0; t < 16; ++t) {
                        const float r = (float)((const LAS _Float16*)(lds + R_OFF))[t * XCS + c], ig = (float)((const LAS _Float16*)(lds + I_OFF))[t * XCS + c];
                        const float la = r * k8, a = __expf(la), mult = __builtin_amdgcn_sqrtf(fmaxf(1.0f - a * a, 0.0f)), uu = mult * (ig * xc[t]);
                        const float hh = a * h0[t] + uu;
                        (P->out + O_SH + (size_t)(l * MS + b0 + t) * GWID)[c] = hh;
                        (MIX + (srow0 + t) * D)[c] = f2bf(hh * gelu_tanh(gt[t]));
                    }
                    __syncthreads();
                }
            }
        }
        if (ph != DEPTH * NK - 1) GSYNC();
#ifdef TIME_CLASS
        { const int cls = (kind == 0 || kind == 7) ? 0 : (kind == 1 || kind == 8) ? 1 : (kind == 3 || kind == 5) ? 2 : (kind == 4) ? 4 : 3;
          if (cls == TIME_CLASS) t_acc += __builtin_amdgcn_s_memrealtime() - t_beg; }
#endif
    }
#ifdef TIME_CLASS
    if (blockIdx.x == 0) { const unsigned long long t0 = __builtin_amdgcn_s_memrealtime(); while (__builtin_amdgcn_s_memrealtime() - t0 < t_acc) __builtin_amdgcn_s_sleep(8); }
#endif
}

extern "C" void kernel_launch(void* const* d_in, const int* in_sizes, int n_in, void* d_out, int out_size, void* d_ws, size_t ws_size, hipStream_t stream) {
    static int grid_blocks = 0;
    if (!grid_blocks) {
        int dev = 0, cus = 0, per_cu = 0;
        hipGetDevice(&dev);
        hipDeviceGetAttribute(&cus, hipDeviceAttributeMultiprocessorCount, dev);
        hipFuncSetAttribute((const void*)fwd_megakernel, hipFuncAttributeMaxDynamicSharedMemorySize, LDS_BYTES);
        hipOccupancyMaxActiveBlocksPerMultiprocessor(&per_cu, (const void*)fwd_megakernel, NTHR, LDS_BYTES);
        if (per_cu < 1) per_cu = 1;
        grid_blocks = cus * per_cu;
        if (grid_blocks > 256) grid_blocks = 256;
        if (ws_size < WS_END) fprintf(stderr, "kernel_launch: workspace too small: %zu < %zu\n", ws_size, (size_t)WS_END);
    }
    Params p{};
    for (int i = 0; i < 24; ++i) p.in[i] = (const float*)d_in[i];
    p.out = (float*)d_out; p.ws = (unsigned char*)d_ws;
    (void)hipMemsetAsync((unsigned char*)d_ws + WS_BAR, 0, 16384, stream);
    void* args[] = {&p};
    hipError_t e = hipLaunchCooperativeKernel((const void*)fwd_megakernel, dim3(grid_blocks), dim3(NTHR), args, LDS_BYTES, stream);
    if (e != hipSuccess) fprintf(stderr, "cooperative launch failed: %s (grid %d)\n", hipGetErrorString(e), grid_blocks);
}
```
